# Optimizing an MI355X kernel written in HIP

```python
import jax, jax.numpy as jnp
from jax import lax
import numpy as np

D_MODEL = 1024
BATCH = 8
SEQ = 4096
DEPTH = 1

N_META = 16
CHUNK = 64
N_PAD = CHUNK - N_META
GLA_HEADS = 4
GLA_DK = 128
GLA_DV = 256
GLA_KEY = GLA_HEADS * GLA_DK
GLA_VAL = GLA_HEADS * GLA_DV
GATE_RANK = 16
GATE_TAU = 16.0
SSM_WIDTH = D_MODEL
SSM_GROUP = 16
SSM_GROUPS = SSM_WIDTH // SSM_GROUP
SSM_STATE = 64
D_FF = 4 * D_MODEL
EPS = 1e-6

Q_END = GLA_KEY
K_END = Q_END + GLA_KEY
V_END = K_END + GLA_VAL
R_END = V_END + GLA_VAL
A_END = R_END + GATE_RANK
U_END = A_END + SSM_WIDTH
G1_END = U_END + D_MODEL
IN_WIDTH = G1_END + D_MODEL

kernel_name = "hybrid_gla_s5_gated_block"


def rmsnorm(x, g):
    xf = x.astype(jnp.float32)
    ms = jnp.mean(xf * xf, axis=-1, keepdims=True)
    return (xf * lax.rsqrt(ms + EPS) * g.astype(jnp.float32)).astype(x.dtype)


def gla_chunked(q, k, v, log_a):
    bsz, p, h, dk = q.shape
    dv = v.shape[-1]
    nc = p // CHUNK

    def to_chunks(t):
        return t.reshape(bsz, nc, CHUNK, h, t.shape[-1]).transpose(1, 0, 3, 2, 4)

    qc, kc, vc = to_chunks(q), to_chunks(k), to_chunks(v)
    b = jnp.cumsum(to_chunks(log_a).astype(jnp.float32), axis=3)
    b_ref = b[:, :, :, CHUNK // 2:CHUNK // 2 + 1, :]
    q_in = qc * jnp.exp(b - b_ref)
    k_in = kc * jnp.exp(b_ref - b)
    mask = jnp.tril(jnp.ones((CHUNK, CHUNK), dtype=bool))
    scores = jnp.where(mask, jnp.einsum('nbhid,nbhjd->nbhij', q_in, k_in), 0.0)
    o_intra = jnp.einsum('nbhij,nbhjv->nbhiv', scores, vc.astype(jnp.float32))

    b_last = b[:, :, :, -1:, :]
    q_inter = qc * jnp.exp(b)
    k_state = kc * jnp.exp(b_last - b)
    decay_chunk = jnp.exp(b_last[:, :, :, 0, :])

    def step(state, inp):
        qi, ks, vv, dc = inp
        o = jnp.einsum('bhid,bhdv->bhiv', qi, state)
        new_state = dc[..., None] * state + jnp.einsum('bhjd,bhjv->bhdv', ks, vv.astype(jnp.float32))
        return new_state, o

    s0 = jnp.zeros((bsz, h, dk, dv), jnp.float32)
    _, o_inter = lax.scan(step, s0, (q_inter, k_state, vc, decay_chunk))
    o = (o_intra + o_inter).transpose(1, 0, 3, 2, 4).reshape(bsz, p, h, dv)
    return o.astype(v.dtype)


def _complex_combine(e1, e2):
    a1r, a1i, b1r, b1i = e1
    a2r, a2i, b2r, b2i = e2
    return (a2r * a1r - a2i * a1i,
            a2r * a1i + a2i * a1r,
            a2r * b1r - a2i * b1i + b2r,
            a2r * b1i + a2i * b1r + b2i)


def s5_ssm(u, a_re, a_im, log_step, b_re, b_im, c_re, c_im, d_skip):
    bsz, p, _ = u.shape
    g, n, hg = SSM_GROUPS, SSM_STATE, SSM_GROUP
    ar = a_re.astype(jnp.float32)
    ai = a_im.astype(jnp.float32)
    dt = jnp.exp(log_step.astype(jnp.float32))[:, None]
    mag = jnp.exp(ar * dt)
    lam_re, lam_im = mag * jnp.cos(ai * dt), mag * jnp.sin(ai * dt)
    zr, zi = lam_re - 1.0, lam_im
    den = ar * ar + ai * ai
    fr = (zr * ar + zi * ai) / den
    fi = (zi * ar - zr * ai) / den
    br, bi = b_re.astype(jnp.float32), b_im.astype(jnp.float32)
    bb_re = fr[..., None] * br - fi[..., None] * bi
    bb_im = fr[..., None] * bi + fi[..., None] * br
    cr, ci = c_re.astype(jnp.float32), c_im.astype(jnp.float32)

    nc = p // CHUNK
    uc = u.reshape(bsz, nc, CHUNK, g, hg).transpose(1, 0, 2, 3, 4)
    lam_b_re = jnp.broadcast_to(lam_re, (bsz, CHUNK, g, n))
    lam_b_im = jnp.broadcast_to(lam_im, (bsz, CHUNK, g, n))

    def step(carry, u_blk):
        h_re, h_im = carry
        uf = u_blk.astype(jnp.float32)
        bu_re = jnp.einsum('bcgh,gnh->bcgn', uf, bb_re)
        bu_im = jnp.einsum('bcgh,gnh->bcgn', uf, bb_im)
        acc_re, acc_im, x_re, x_im = lax.associative_scan(
            _complex_combine, (lam_b_re, lam_b_im, bu_re, bu_im), axis=1)
        s_re = x_re + acc_re * h_re[:, None] - acc_im * h_im[:, None]
        s_im = x_im + acc_re * h_im[:, None] + acc_im * h_re[:, None]
        y = jnp.einsum('bcgn,ghn->bcgh', s_re, cr) - jnp.einsum('bcgn,ghn->bcgh', s_im, ci)
        return (s_re[:, -1], s_im[:, -1]), y

    carry0 = (jnp.zeros((bsz, g, n), jnp.float32), jnp.zeros((bsz, g, n), jnp.float32))
    _, y = lax.scan(step, carry0, uc)
    y = y.transpose(1, 0, 2, 3, 4).reshape(bsz, p, g * hg)
    return (y + d_skip.astype(jnp.float32) * u.astype(jnp.float32)).astype(u.dtype)


def setup_inputs(seed: int = 0) -> dict:
    key = jax.random.key(seed)
    ks = jax.random.split(key, 24)
    nrm = lambda k, shape, s: jax.random.normal(k, shape, jnp.float32) * s
    gain = lambda k, shape: 1.0 + 0.05 * jax.random.normal(k, shape, jnp.float32)
    L = DEPTH
    x = jax.random.normal(ks[0], (BATCH, SEQ, D_MODEL), jnp.float32)
    meta_tokens = nrm(ks[1], (N_META, D_MODEL), 1.0)
    g_mix_pre = gain(ks[2], (L, D_MODEL))
    w_in = nrm(ks[3], (L, D_MODEL, IN_WIDTH), D_MODEL ** -0.5)
    w_gate_up = nrm(ks[4], (L, GATE_RANK, GLA_KEY), GATE_RANK ** -0.5)
    b_gate = 1.0 + 0.5 * jax.random.normal(ks[5], (L, GLA_KEY), jnp.float32)
    gla_norm_g = gain(ks[6], (L, GLA_HEADS, GLA_DV))
    w_o_gla = nrm(ks[7], (L, GLA_VAL, D_MODEL), GLA_VAL ** -0.5)
    n_idx = jnp.arange(SSM_STATE, dtype=jnp.float32)
    a_re = -0.5 + 0.01 * jax.random.normal(ks[8], (L, SSM_GROUPS, SSM_STATE), jnp.float32)
    a_im = jnp.broadcast_to(jnp.pi * n_idx, (L, SSM_GROUPS, SSM_STATE)) + 0.0
    log_step = jax.random.uniform(ks[9], (L, SSM_GROUPS), jnp.float32,
                                  minval=float(np.log(1e-3)), maxval=float(np.log(1e-1)))
    b_re = nrm(ks[10], (L, SSM_GROUPS, SSM_STATE, SSM_GROUP), (2 * SSM_GROUP) ** -0.5)
    b_im = nrm(ks[11], (L, SSM_GROUPS, SSM_STATE, SSM_GROUP), (2 * SSM_GROUP) ** -0.5)
    c_re = nrm(ks[12], (L, SSM_GROUPS, SSM_GROUP, SSM_STATE), (2 * SSM_STATE) ** -0.5)
    c_im = nrm(ks[13], (L, SSM_GROUPS, SSM_GROUP, SSM_STATE), (2 * SSM_STATE) ** -0.5)
    d_skip = nrm(ks[14], (L, SSM_WIDTH), 1.0)
    w_glu = nrm(ks[15], (L, SSM_WIDTH, 2 * D_MODEL), SSM_WIDTH ** -0.5)
    b_glu = nrm(ks[16], (L, 2 * D_MODEL), 0.02)
    w_out = nrm(ks[17], (L, D_MODEL, D_MODEL), D_MODEL ** -0.5)
    g_mix_post = gain(ks[18], (L, D_MODEL))
    g_ffn_pre = gain(ks[19], (L, D_MODEL))
    w_ff1 = nrm(ks[20], (L, D_MODEL, D_FF), D_MODEL ** -0.5)
    w_ff2 = nrm(ks[21], (L, D_FF, D_MODEL), D_FF ** -0.5)
    g_ffn_post = gain(ks[22], (L, D_MODEL))
    return {"x": x, "meta_tokens": meta_tokens, "g_mix_pre": g_mix_pre, "w_in": w_in,
            "w_gate_up": w_gate_up, "b_gate": b_gate, "gla_norm_g": gla_norm_g, "w_o_gla": w_o_gla,
            "a_re": a_re, "a_im": a_im, "log_step": log_step, "b_re": b_re, "b_im": b_im,
            "c_re": c_re, "c_im": c_im, "d_skip": d_skip, "w_glu": w_glu, "b_glu": b_glu,
            "w_out": w_out, "g_mix_post": g_mix_post, "g_ffn_pre": g_ffn_pre, "w_ff1": w_ff1,
            "w_ff2": w_ff2, "g_ffn_post": g_ffn_post}


def reference(x, meta_tokens, g_mix_pre, w_in, w_gate_up, b_gate, gla_norm_g, w_o_gla,
              a_re, a_im, log_step, b_re, b_im, c_re, c_im, d_skip, w_glu, b_glu,
              w_out, g_mix_post, g_ffn_pre, w_ff1, w_ff2, g_ffn_post):
    bsz, seq, dm = x.shape
    meta = jnp.broadcast_to(meta_tokens.astype(x.dtype)[None], (bsz, N_META, dm))
    h = jnp.concatenate([meta, x], axis=1)
    p = N_PAD + N_META + seq

    def pad(t):
        return jnp.pad(t, ((0, 0), (N_PAD, 0), (0, 0)))

    def heads(t, d):
        return t.reshape(bsz, p, GLA_HEADS, d)

    for l in range(DEPTH):
        xn = rmsnorm(h, g_mix_pre[l])
        proj = xn @ w_in[l]
        q = proj[..., :Q_END]
        k = proj[..., Q_END:K_END]
        v = proj[..., K_END:V_END]
        r = proj[..., V_END:R_END]
        a_low = proj[..., R_END:A_END]
        u = proj[..., A_END:U_END]
        z_gla = proj[..., U_END:G1_END]
        z_ssm = proj[..., G1_END:]

        log_a = jax.nn.log_sigmoid((a_low @ w_gate_up[l] + b_gate[l]).astype(jnp.float32)) / GATE_TAU
        o = gla_chunked(heads(pad(q), GLA_DK) * (GLA_DK ** -0.5), heads(pad(k), GLA_DK),
                        heads(pad(v), GLA_DV), heads(pad(log_a), GLA_DK))[:, N_PAD:]
        o = rmsnorm(o, gla_norm_g[l]).reshape(bsz, N_META + seq, GLA_VAL) * jax.nn.silu(r)
        y_gla = o @ w_o_gla[l]

        y_s = s5_ssm(pad(u), a_re[l], a_im[l], log_step[l], b_re[l], b_im[l],
                     c_re[l], c_im[l], d_skip[l])[:, N_PAD:]
        g_s = jax.nn.gelu(y_s)
        glu = g_s @ w_glu[l] + b_glu[l]
        y_ssm = glu[..., :D_MODEL] * jax.nn.sigmoid(glu[..., D_MODEL:])

        mixed = jax.nn.sigmoid(z_gla) * y_gla + jax.nn.sigmoid(z_ssm) * y_ssm
        h = h + rmsnorm(mixed @ w_out[l], g_mix_post[l])

        hn = rmsnorm(h, g_ffn_pre[l])
        f = jnp.square(jax.nn.relu(hn @ w_ff1[l])) @ w_ff2[l]
        h = h + rmsnorm(f, g_ffn_post[l])

    return h[:, N_META:]
```

```cpp
#include <hip/hip_runtime.h>
#include <cstdio>
#include <cstdint>

#ifndef MK_N_LAUNCHES
#define MK_N_LAUNCHES 1
#endif

namespace pg8 {
#define PG8_LAS __attribute__((address_space(3)))
typedef unsigned short bf16_t;
typedef short bf16x8 __attribute__((ext_vector_type(8)));
typedef float f32x4 __attribute__((ext_vector_type(4)));
typedef float f32x2 __attribute__((ext_vector_type(2)));
typedef unsigned u32x4 __attribute__((ext_vector_type(4)));
constexpr int BM = 256, BK = 64, HALF = 128, HTB = HALF * BK * 2, STAGE_BYTES = 8 * HTB, NXCD = 8, WGM = 8;

__host__ __device__ __forceinline__ int lds_byte(int r, int c) { const int st = (r >> 4) * 2 + (c >> 5), rr = r & 15, cc = c & 31, ob = rr * 64 + cc * 2; return st * 1024 + (ob ^ (((ob >> 9) & 1) << 5)); }
__host__ __device__ __forceinline__ void stage_rc(int b, int& R, int& C) { const int st = b / 1024, sb = b % 1024, swz = sb ^ (((sb >> 9) & 1) << 5); R = (st >> 1) * 16 + swz / 64; C = (st & 1) * 32 + (swz % 64) / 2; }
__host__ __device__ __forceinline__ int perm32(int rho) { const int n = rho >> 4, i = rho & 15; return 8 * (i >> 2) + 4 * n + (i & 3); }

struct Unit { int pm, pn; };
struct Gemm { const bf16_t* A; const bf16_t* Bt; int lda, ldb, K, tstepB_rows; };

struct StaticOrder {
    int nM, nN, nwg, G, c;
    __host__ __device__ void init(int M, int N, int G_, int c_) { nM = M / BM; nN = N / BM; nwg = nM * nN; G = G_; c = c_; }
    __host__ __device__ bool next(int i, Unit& u) const {
        const long L = (long)i * G + c; if (L >= nwg) return false;
        int wgid = (int)L; { const int q = nwg / NXCD, r = nwg % NXCD, xcd = wgid % NXCD, off = wgid / NXCD; wgid = (xcd < r ? xcd * (q + 1) : r * (q + 1) + (xcd - r) * q) + off; }
        const int nig = WGM * nN, gid = wgid / nig, fm = gid * WGM, gsz = (nM - fm) < WGM ? (nM - fm) : WGM;
        u.pm = fm + ((wgid % nig) % gsz); u.pn = (wgid % nig) / gsz; return true;
    }
};
struct GroupOrder {
    int G, c;
    __host__ __device__ bool next(int i, Unit& u) const { const int L = i * G + c; if (L >= 512) return false; u.pm = L; u.pn = L >> 3; return true; }
};

__device__ __forceinline__ unsigned cvt_pk_bf16(float lo, float hi) { unsigned r; asm volatile("v_cvt_pk_bf16_f32 %0, %1, %2" : "=v"(r) : "v"(lo), "v"(hi)); return r; }
__device__ __forceinline__ float bflo(unsigned w) { return __uint_as_float(w << 16); }
__device__ __forceinline__ float bfhi(unsigned w) { return __uint_as_float(w & 0xffff0000u); }
__device__ __forceinline__ float sigmoidf_(float x) { return __builtin_amdgcn_rcpf(1.0f + __expf(-x)); }
__device__ __forceinline__ float logsigf_(float x) { return fminf(x, 0.f) - log1pf(__expf(-fabsf(x))); }
__device__ __forceinline__ float gelu_tanh(float x) { const float z = 0.7978845608028654f * (x + 0.044715f * x * x * x); return x * __builtin_amdgcn_rcpf(1.0f + __expf(-2.0f * z)); }
__device__ __forceinline__ u32x4 pack8(const f32x4& a, const f32x4& b) { u32x4 w; w.x = cvt_pk_bf16(a[0], a[1]); w.y = cvt_pk_bf16(a[2], a[3]); w.z = cvt_pk_bf16(b[0], b[1]); w.w = cvt_pk_bf16(b[2], b[3]); return w; }

struct EpiF32 {
    static constexpr bool PERM = false;
    float* C; int ldc;
    __device__ __forceinline__ void operator()(const f32x4 (&acc)[2][2][4][2], const Unit& u, int wr, int wc, int fr, int fq) const {
        const int row0 = u.pm * BM + wr * 64 + fr, col0 = u.pn * BM + wc * 32 + 4 * fq;
#pragma unroll
        for (int ai = 0; ai < 2; ++ai)
#pragma unroll
            for (int m = 0; m < 4; ++m) { float* rowp = C + (size_t)(row0 + ai * HALF + m * 16) * ldc + col0;
#pragma unroll
                for (int bj = 0; bj < 2; ++bj)
#pragma unroll
                    for (int n = 0; n < 2; ++n) *(f32x4*)(rowp + bj * HALF + n * 16) = acc[ai][bj][m][n]; }
    }
};
struct EpiIn {
    static constexpr bool PERM = true;
    bf16_t *Q, *K, *V, *SR, *UH, *SZG, *SZS, *LA; const float* b_gate;
    template <int KIND>
    __device__ __forceinline__ void run(const f32x4 (&acc)[2][2][4][2], bf16_t* base, int ld, int row0, int col0) const {
#pragma unroll
        for (int bj = 0; bj < 2; ++bj) {
            const int c = col0 + bj * HALF;
            f32x4 b0 = (f32x4){0.f, 0.f, 0.f, 0.f}, b1 = b0;
            if (KIND == 5) { b0 = *(const f32x4*)(b_gate + c); b1 = *(const f32x4*)(b_gate + c + 4); }
#pragma unroll
            for (int ai = 0; ai < 2; ++ai)
#pragma unroll
                for (int m = 0; m < 4; ++m) {
                    const int row = row0 + ai * HALF + m * 16;
                    f32x4 v0 = acc[ai][bj][m][0], v1 = acc[ai][bj][m][1];
                    if (KIND == 0) { v0 = v0 * 0.08838834764831845f; v1 = v1 * 0.08838834764831845f; }
                    if (KIND == 2) {
#pragma unroll
                        for (int j = 0; j < 4; ++j) { v0[j] = v0[j] * sigmoidf_(v0[j]); v1[j] = v1[j] * sigmoidf_(v1[j]); } }
                    if (KIND == 4) {
#pragma unroll
                        for (int j = 0; j < 4; ++j) { v0[j] = sigmoidf_(v0[j]); v1[j] = sigmoidf_(v1[j]); } }
                    if (KIND == 5) {
#pragma unroll
                        for (int j = 0; j < 4; ++j) { v0[j] = logsigf_(v0[j] + b0[j]) * 0.0625f; v1[j] = logsigf_(v1[j] + b1[j]) * 0.0625f; } }
                    bf16_t* p = (KIND == 3) ? base + ((size_t)((c >> 4) * 2048 + (row >> 4)) * 384 + (row & 15) * 16 + (c & 15))
                                            : base + ((size_t)row * ld + c);
                    *(u32x4*)p = pack8(v0, v1);
                }
        }
    }
    __device__ __forceinline__ void operator()(const f32x4 (&acc)[2][2][4][2], const Unit& u, int wr, int wc, int fr, int fq) const {
        const int pn = u.pn; const int row0 = u.pm * BM + wr * 64 + fr, cw = wc * 32 + 8 * fq;
        if (pn < 2)       run<0>(acc, Q, 512, row0, pn * 256 + cw);
        else if (pn < 4)  run<1>(acc, K, 512, row0, (pn - 2) * 256 + cw);
        else if (pn < 8)  run<1>(acc, V, 1024, row0, (pn - 4) * 256 + cw);
        else if (pn < 12) run<2>(acc, SR, 1024, row0, (pn - 8) * 256 + cw);
        else if (pn < 16) run<3>(acc, UH, 0, row0, (pn - 12) * 256 + cw);
        else if (pn < 20) run<4>(acc, SZG, 1024, row0, (pn - 16) * 256 + cw);
        else if (pn < 24) run<4>(acc, SZS, 1024, row0, (pn - 20) * 256 + cw);
        else              run<5>(acc, LA, 512, row0, (pn - 24) * 256 + cw);
    }
};
struct EpiE {
    static constexpr bool PERM = true;
    bf16_t* UH;
    __device__ __forceinline__ void operator()(const f32x4 (&acc)[2][2][4][2], const Unit& u, int wr, int wc, int fr, int fq) const {
        const int row0 = u.pm * BM + wr * 64 + fr, col0 = 256 + wc * 32 + 8 * fq;
#pragma unroll
        for (int ai = 0; ai < 2; ++ai)
#pragma unroll
            for (int m = 0; m < 4; ++m) *(u32x4*)(UH + (size_t)(row0 + ai * HALF + m * 16) * 384 + col0) = pack8(acc[ai][0][m][0], acc[ai][0][m][1]);
    }
};
struct EpiS {
    static constexpr bool PERM = true;
    bf16_t* GS;
    __device__ __forceinline__ void operator()(const f32x4 (&acc)[2][2][4][2], const Unit& u, int wr, int wc, int fr, int fq) const {
        const int g = u.pn; const int rg0 = (u.pm & 7) * BM + wr * 64 + fr;
        bf16_t* base = GS + ((size_t)(rg0 * 16 + wc * 2 + (fq >> 1)) * 1024 + g * 16 + (fq & 1) * 8);
#pragma unroll
        for (int ai = 0; ai < 2; ++ai)
#pragma unroll
            for (int m = 0; m < 4; ++m) {
#pragma unroll
                for (int bj = 0; bj < 2; ++bj) {
                    f32x4 v0 = acc[ai][bj][m][0], v1 = acc[ai][bj][m][1];
#pragma unroll
                    for (int j = 0; j < 4; ++j) { v0[j] = gelu_tanh(v0[j]); v1[j] = gelu_tanh(v1[j]); }
                    *(u32x4*)(base + (size_t)(ai * HALF + m * 16) * 16384 + bj * 8192) = pack8(v0, v1); }
                asm volatile("" ::: "memory"); }
    }
};
struct EpiYG {
    static constexpr bool PERM = true;
    const bf16_t* SZG; bf16_t* YG;
    __device__ __forceinline__ void operator()(const f32x4 (&acc)[2][2][4][2], const Unit& u, int wr, int wc, int fr, int fq) const {
        const int row0 = u.pm * BM + wr * 64 + fr, col0 = u.pn * BM + wc * 32 + 8 * fq;
#pragma unroll
        for (int ai = 0; ai < 2; ++ai)
#pragma unroll
            for (int m = 0; m < 4; ++m)
#pragma unroll
                for (int bj = 0; bj < 2; ++bj) { const size_t off = (size_t)(row0 + ai * HALF + m * 16) * 1024 + col0 + bj * HALF;
                    const u32x4 z = *(const u32x4*)(SZG + off); f32x4 v0 = acc[ai][bj][m][0], v1 = acc[ai][bj][m][1];
                    v0[0] *= bflo(z.x); v0[1] *= bfhi(z.x); v0[2] *= bflo(z.y); v0[3] *= bfhi(z.y); v1[0] *= bflo(z.z); v1[1] *= bfhi(z.z); v1[2] *= bflo(z.w); v1[3] *= bfhi(z.w);
                    *(u32x4*)(YG + off) = pack8(v0, v1); }
    }
};
struct EpiGlu {
    static constexpr bool PERM = true;
    const bf16_t *YG, *SZS; bf16_t* MIX; const float* b_glu;
    __device__ __forceinline__ void operator()(const f32x4 (&acc)[2][2][4][2], const Unit& u, int wr, int wc, int fr, int fq) const {
        const int row0 = u.pm * BM + wr * 64 + fr, c = u.pn * HALF + wc * 32 + 8 * fq;
        const f32x4 bv0 = *(const f32x4*)(b_glu + c), bv1 = *(const f32x4*)(b_glu + c + 4), bg0 = *(const f32x4*)(b_glu + 1024 + c), bg1 = *(const f32x4*)(b_glu + 1024 + c + 4);
#pragma unroll
        for (int ai = 0; ai < 2; ++ai)
#pragma unroll
            for (int m = 0; m < 4; ++m) { const size_t off = (size_t)(row0 + ai * HALF + m * 16) * 1024 + c;
                const u32x4 y = *(const u32x4*)(YG + off), z = *(const u32x4*)(SZS + off);
                f32x4 v0 = acc[ai][0][m][0] + bv0, v1 = acc[ai][0][m][1] + bv1, g0 = acc[ai][1][m][0] + bg0, g1 = acc[ai][1][m][1] + bg1;
#pragma unroll
                for (int j = 0; j < 4; ++j) { v0[j] *= sigmoidf_(g0[j]); v1[j] *= sigmoidf_(g1[j]); }
                v0[0] = bflo(y.x) + bflo(z.x) * v0[0]; v0[1] = bfhi(y.x) + bfhi(z.x) * v0[1]; v0[2] = bflo(y.y) + bflo(z.y) * v0[2]; v0[3] = bfhi(y.y) + bfhi(z.y) * v0[3];
                v1[0] = bflo(y.z) + bflo(z.z) * v1[0]; v1[1] = bfhi(y.z) + bfhi(z.z) * v1[1]; v1[2] = bflo(y.w) + bflo(z.w) * v1[2]; v1[3] = bfhi(y.w) + bfhi(z.w) * v1[3];
                *(u32x4*)(MIX + off) = pack8(v0, v1); }
    }
};
struct EpiRelu2 {
    static constexpr bool PERM = true;
    bf16_t* O; int ldc;
    __device__ __forceinline__ void operator()(const f32x4 (&acc)[2][2][4][2], const Unit& u, int wr, int wc, int fr, int fq) const {
        const int row0 = u.pm * BM + wr * 64 + fr, col0 = u.pn * BM + wc * 32 + 8 * fq;
#pragma unroll
        for (int ai = 0; ai < 2; ++ai)
#pragma unroll
            for (int m = 0; m < 4; ++m)
#pragma unroll
                for (int bj = 0; bj < 2; ++bj) { f32x4 v0 = acc[ai][bj][m][0], v1 = acc[ai][bj][m][1];
#pragma unroll
                    for (int j = 0; j < 4; ++j) { const float a = fmaxf(v0[j], 0.f), b = fmaxf(v1[j], 0.f); v0[j] = a * a; v1[j] = b * b; }
                    *(u32x4*)(O + (size_t)(row0 + ai * HALF + m * 16) * ldc + col0 + bj * HALF) = pack8(v0, v1); }
    }
};

template <class Epi, class Sched, bool ALIGN_EPI>
__device__ __forceinline__ void gemm_phase(PG8_LAS unsigned char* lds, const Gemm g, const Sched& S, const Epi& E, const int wid  ) {
    int lane_ = (int)__builtin_amdgcn_mbcnt_hi(~0u, __builtin_amdgcn_mbcnt_lo(~0u, 0u)); asm volatile("" : "+v"(lane_));
    const int lane = lane_, tid = wid * 64 + lane, wr = wid >> 2, wc = wid & 3, fr = lane & 15, fq = lane >> 4;
    const int nt = g.K / BK;
    unsigned voffA[2], voffB[2];
#pragma unroll
    for (int i = 0; i < 2; ++i) { int R, C; stage_rc(tid * 16 + i * 8192, R, C); const int Rb = Epi::PERM ? ((R & ~31) + perm32(R & 31)) : R;
        voffA[i] = (unsigned)(R * g.lda + C) * 2u; voffB[i] = (unsigned)(Rb * g.ldb + C) * 2u; }
    const size_t kstep = (size_t)(BK * 2);
    const size_t hstepA = (size_t)HALF * g.lda * 2, hstepB = (size_t)HALF * g.ldb * 2;
    const size_t tstepA = 2 * hstepA, tstepB = (size_t)g.tstepB_rows * g.ldb * 2;
    const unsigned ldsw = (unsigned)wid * 1024u;
    const int aoff = lds_byte(wr * 64 + fr, fq * 8), boff = lds_byte(wc * 32 + fr, fq * 8);
#define PG8_SA(b, h) (((b) * 2 + (h)) * HTB)
#define PG8_SB(b, h) ((4 + (b) * 2 + (h)) * HTB)
#define PG8_STAGE(bufoff, gbase, voff) do { _Pragma("unroll") for (int _i = 0; _i < 2; ++_i) \
        __builtin_amdgcn_global_load_lds((const unsigned*)((const char*)(gbase) + (voff)[_i]), (PG8_LAS unsigned*)(lds + (bufoff) + ldsw + _i * 8192), 16, 0, 0); } while (0)
#define PG8_LDA(dst, b, h) do { _Pragma("unroll") for (int m = 0; m < 4; ++m) _Pragma("unroll") for (int k = 0; k < 2; ++k) dst[m][k] = *(const PG8_LAS bf16x8*)(lds + PG8_SA(b, h) + aoff + m * 2048 + k * 1024); } while (0)
#define PG8_LDB(dst, b, h) do { _Pragma("unroll") for (int n = 0; n < 2; ++n) _Pragma("unroll") for (int k = 0; k < 2; ++k) dst[n][k] = *(const PG8_LAS bf16x8*)(lds + PG8_SB(b, h) + boff + n * 2048 + k * 1024); } while (0)
#define PG8_MMA(ai, bj, At, Bt) do { __builtin_amdgcn_s_setprio(1); _Pragma("unroll") for (int m = 0; m < 4; ++m) _Pragma("unroll") for (int n = 0; n < 2; ++n) _Pragma("unroll") for (int k = 0; k < 2; ++k) \
        acc[ai][bj][m][n] = __builtin_amdgcn_mfma_f32_16x16x32_bf16(Bt[n][k], At[m][k], acc[ai][bj][m][n], 0, 0, 0); __builtin_amdgcn_s_setprio(0); } while (0)
#define PG8_WAIT_V(n) asm volatile("s_waitcnt vmcnt(" #n ")" ::: "memory")
#define PG8_WAIT_L(n) asm volatile("s_waitcnt lgkmcnt(" #n ")" ::: "memory")
#define PG8_BAR __builtin_amdgcn_s_barrier()
#define PG8_SCHED __builtin_amdgcn_sched_barrier(0)
    Unit cur, nxt; int ui = 0;
    if (!S.next(0, cur)) return;
    f32x4 acc[2][2][4][2];
#pragma unroll
    for (int a = 0; a < 2; ++a)
#pragma unroll
        for (int b = 0; b < 2; ++b)
#pragma unroll
            for (int m = 0; m < 4; ++m)
#pragma unroll
                for (int n = 0; n < 2; ++n) acc[a][b][m][n] = (f32x4){0.f, 0.f, 0.f, 0.f};
    bf16x8 At[4][2], B0[2][2], B1[2][2];
    const char* cA = (const char*)g.A + (size_t)cur.pm * tstepA; const char* cB = (const char*)g.Bt + (size_t)cur.pn * tstepB;
    PG8_STAGE(PG8_SB(0, 0), cB, voffB); PG8_STAGE(PG8_SB(0, 1), cB + hstepB, voffB); PG8_STAGE(PG8_SA(0, 0), cA, voffA); PG8_STAGE(PG8_SA(0, 1), cA + hstepA, voffA);
    if (wr == 1) PG8_BAR;
    PG8_WAIT_V(2); PG8_BAR;
    PG8_STAGE(PG8_SB(1, 0), cB + kstep, voffB); PG8_STAGE(PG8_SA(1, 0), cA + kstep, voffA); PG8_STAGE(PG8_SB(1, 1), cB + hstepB + kstep, voffB);
    PG8_WAIT_V(6); PG8_BAR;
    for (;;) {
        const bool has_next = S.next(ui + 1, nxt);
        const char* nA = has_next ? (const char*)g.A + (size_t)nxt.pm * tstepA : cA; const char* nB = has_next ? (const char*)g.Bt + (size_t)nxt.pn * tstepB : cB;
        for (int t = 0; t < nt; t += 2) {
            const bool last = (t == nt - 2);
            const char* a1 = cA + (size_t)(t + 1) * kstep;
            const char* a2 = last ? nA : cA + (size_t)(t + 2) * kstep; const char* b2 = last ? nB : cB + (size_t)(t + 2) * kstep;
            const char* a3 = a2 + kstep; const char* b3 = b2 + kstep;
            PG8_LDB(B0, 0, 0); PG8_LDB(B1, 0, 1); PG8_SCHED; PG8_LDA(At, 0, 0); PG8_STAGE(PG8_SA(1, 1), a1 + hstepA, voffA);
            PG8_WAIT_V(8); PG8_WAIT_L(0); PG8_BAR; PG8_MMA(0, 0, At, B0); PG8_MMA(0, 1, At, B1); PG8_BAR; PG8_SCHED;
            PG8_LDA(At, 0, 1); PG8_STAGE(PG8_SB(0, 0), b2, voffB); PG8_STAGE(PG8_SB(0, 1), b2 + hstepB, voffB); PG8_STAGE(PG8_SA(0, 0), a2, voffA);
            PG8_WAIT_V(8); PG8_WAIT_L(0); PG8_BAR; PG8_MMA(1, 0, At, B0); PG8_MMA(1, 1, At, B1); PG8_BAR; PG8_SCHED;
            PG8_LDB(B0, 1, 0); PG8_LDB(B1, 1, 1); PG8_SCHED; PG8_LDA(At, 1, 0); PG8_STAGE(PG8_SA(0, 1), a2 + hstepA, voffA);
            PG8_WAIT_V(8); PG8_WAIT_L(0); PG8_BAR; PG8_MMA(0, 0, At, B0); PG8_MMA(0, 1, At, B1); PG8_BAR; PG8_SCHED;
            PG8_LDA(At, 1, 1); PG8_STAGE(PG8_SB(1, 0), b3, voffB); PG8_STAGE(PG8_SB(1, 1), b3 + hstepB, voffB); PG8_STAGE(PG8_SA(1, 0), a3, voffA);
            PG8_WAIT_V(8); PG8_WAIT_L(0); PG8_BAR; PG8_MMA(1, 0, At, B0); PG8_MMA(1, 1, At, B1); PG8_BAR; PG8_SCHED;
        }
        if constexpr (ALIGN_EPI) { if (wr == 0) PG8_BAR; }
        { int le = (int)__builtin_amdgcn_mbcnt_hi(~0u, __builtin_amdgcn_mbcnt_lo(~0u, 0u)); asm volatile("" : "+v"(le)); E(acc, cur, wr, wc, le & 15, le >> 4); }
        if (!has_next) break;
#pragma unroll
        for (int a = 0; a < 2; ++a)
#pragma unroll
            for (int b = 0; b < 2; ++b)
#pragma unroll
                for (int m = 0; m < 4; ++m)
#pragma unroll
                    for (int n = 0; n < 2; ++n) acc[a][b][m][n] = (f32x4){0.f, 0.f, 0.f, 0.f};
        cur = nxt; cA = nA; cB = nB; ++ui;
        if constexpr (ALIGN_EPI) { if (wr == 1) PG8_BAR; }
    }
    PG8_WAIT_V(0);
    if constexpr (!ALIGN_EPI) { if (wr == 0) PG8_BAR; }
    PG8_BAR;
#undef PG8_SA
#undef PG8_SB
#undef PG8_STAGE
#undef PG8_LDA
#undef PG8_LDB
#undef PG8_MMA
#undef PG8_WAIT_V
#undef PG8_WAIT_L
#undef PG8_BAR
#undef PG8_SCHED
}
}

constexpr int NWAVES = 8;
constexpr int BATCH = 8, SEQ = 4096, D = 1024, M = BATCH * SEQ, NMETA = 16;
constexpr int NH = 4, DKH = 128, DVH = 256, GKEY = 512, GVAL = 1024, RANK = 16;
constexpr int SG = 64, SHG = 16, SN = 64, FF = 4096, IN_W = 6160, NIN = 6656;
constexpr int SRC_A = 3072, SRC_U = 3088;
constexpr float EPS = 1e-6f;
constexpr int N_LAUNCHES = MK_N_LAUNCHES;
constexpr int N_PHASES = 11;

constexpr size_t MiB = 1u << 20;
constexpr size_t WS_CTL = 0, CTL_ZERO_BYTES = 1 * MiB;
constexpr size_t WS_SMALL = 1 * MiB;
constexpr size_t WS_WIN = 2 * MiB, WS_WO = 15 * MiB, WS_WGLU = 17 * MiB, WS_WOUT = 21 * MiB, WS_WFF1 = 23 * MiB, WS_WFF2 = 31 * MiB;
constexpr size_t WS_TZ = 39 * MiB;
constexpr size_t WS_MS = 51 * MiB;
constexpr size_t WS_XN = 56 * MiB;
constexpr size_t WS_Q = 120 * MiB, WS_K = 152 * MiB, WS_V = 184 * MiB, WS_SR = 248 * MiB, WS_LA = 312 * MiB, WS_UH = 344 * MiB;
constexpr size_t WS_GS = 120 * MiB;
constexpr size_t WS_YG = 184 * MiB;
constexpr size_t WS_MIX = 248 * MiB;
constexpr size_t WS_T = 312 * MiB;
constexpr size_t WS_F1 = 120 * MiB;
constexpr size_t WS_T2 = 376 * MiB;
constexpr size_t WS_END = 504 * MiB;
constexpr size_t SM_KM = 0;
constexpr size_t SM_VM = SM_KM + 16 * 512 * 4;
constexpr size_t SM_AL = SM_VM + 16 * 1024 * 4;
constexpr size_t SM_UM = SM_AL + 16 * 16 * 4;
constexpr size_t SM_L16 = SM_UM + 16 * 1024 * 4;
constexpr size_t SM_END = SM_L16 + 64 * 64 * 2 * 4;
static_assert(SM_END <= MiB, "small region");
constexpr int CW_BAR = 4096;

constexpr int RING_BYTES = 131072;
constexpr int LDSCTL_OFF = RING_BYTES, MISC_OFF = LDSCTL_OFF + 320;
constexpr int LDS_BYTES = 147456;

#define GAS __attribute__((address_space(1)))
#define LAS __attribute__((address_space(3)))
typedef unsigned short bf16;
typedef unsigned v4u __attribute__((ext_vector_type(4)));
typedef unsigned v2u __attribute__((ext_vector_type(2)));
typedef float f32x4 __attribute__((ext_vector_type(4)));
typedef float f32x16 __attribute__((ext_vector_type(16)));
typedef short bf16x8 __attribute__((ext_vector_type(8)));
#define LDS_WAIT() asm volatile("s_waitcnt lgkmcnt(0)" ::: "memory")
#define VM_WAIT() asm volatile("s_waitcnt vmcnt(0)" ::: "memory")
__device__ __forceinline__ unsigned f2bf(float f) { unsigned u = __builtin_bit_cast(unsigned, f); return (u + 0x7fffu + ((u >> 16) & 1u)) >> 16; }
__device__ __forceinline__ unsigned pk2(float lo, float hi) { return f2bf(lo) | (f2bf(hi) << 16); }
__device__ __forceinline__ float bf2f(bf16 b) { return __uint_as_float((unsigned)b << 16); }

#define XB_TMO      128
#define XB_XCNT(j)  (256  + 64 * (j))
#define XB_XSUB(j)  (1280 + 64 * (j))
#define XB_XGEN(j)  (2304 + 64 * (j))
#define XB_TOP      3328
#define XB_TOPGEN   3392
#define XCD_BAR_WORDS 3456
#define XB_SPIN_CAP (1u << 18)
__device__ __forceinline__ unsigned xb_ld(unsigned* p)              { return __hip_atomic_load(p, __ATOMIC_RELAXED, __HIP_MEMORY_SCOPE_AGENT); }
__device__ __forceinline__ unsigned xb_add(unsigned* p, unsigned v) { return __hip_atomic_fetch_add(p, v, __ATOMIC_RELAXED, __HIP_MEMORY_SCOPE_AGENT); }
__device__ __forceinline__ unsigned xb_xcc_id() { return (unsigned)__builtin_amdgcn_s_getreg((3 << 11) | 20) & 0xFu; }
#define XB_SPIN(cond, bar) do { unsigned _sp = 0; while (cond) { __builtin_amdgcn_s_sleep(1); \
    if ((++_sp & 255u) == 0u) { if (xb_ld(&(bar)[XB_TMO])) break; if (_sp > XB_SPIN_CAP) { atomicAdd(&(bar)[XB_TMO], 1u); break; } } } } while (0)
struct XcdBarrier { unsigned* bar; unsigned x; volatile LAS unsigned* st; };
__device__ __forceinline__ XcdBarrier xcd_barrier_post(unsigned* bar, volatile LAS unsigned* st, bool t0) {
    XcdBarrier b; b.bar = bar; b.x = xb_xcc_id(); b.st = st;
    if (t0) (void)xb_add(&bar[XB_XCNT(b.x)], 1u);
    return b;
}
__device__ __forceinline__ void xcd_barrier_complete(unsigned* bar, unsigned x, unsigned& nloc, unsigned& nx) {
    const unsigned G = gridDim.x * gridDim.y * gridDim.z;
    unsigned sum, cnt, mine, sp = 0u;
    for (;;) {
        sum = 0u; cnt = 0u; mine = 0u;
#pragma unroll
        for (unsigned j = 0; j < 16; ++j) { const unsigned c = xb_ld(&bar[XB_XCNT(j)]); sum += c; cnt += (c > 0u) ? 1u : 0u; mine = (j == x) ? c : mine; }
        if (sum == G) break;
        __builtin_amdgcn_s_sleep(1);
        if ((++sp & 255u) == 0u) { if (xb_ld(&bar[XB_TMO])) break; if (sp > XB_SPIN_CAP) { atomicAdd(&bar[XB_TMO], 1u); break; } }
    }
    nloc = mine > 0u ? mine : 1u; nx = cnt > 0u ? cnt : 1u;
}
__device__ __forceinline__ void xcd_barrier(const XcdBarrier& b, bool t0) {
    asm volatile("s_waitcnt vmcnt(0)" ::: "memory");
    __syncthreads();
    if (t0) {
        unsigned* bar = b.bar;
        __builtin_amdgcn_s_waitcnt(0);
        unsigned nloc = b.st[0], nx = b.st[1];
        if (nloc == 0u) { xcd_barrier_complete(bar, b.x, nloc, nx); b.st[0] = nloc; b.st[1] = nx; }
        const unsigned old = xb_add(&bar[XB_XSUB(b.x)], 1u);
        const unsigned gen = old / nloc;
        if (old + 1u == (gen + 1u) * nloc) {
            __builtin_amdgcn_fence(__ATOMIC_RELEASE, "agent");
            asm volatile("s_waitcnt vmcnt(0)" ::: "memory");
            const unsigned og = xb_add(&bar[XB_TOP], 1u);
            const unsigned tg = og / nx;
            if (og + 1u == (tg + 1u) * nx) xb_add(&bar[XB_TOPGEN], 1u);
            else XB_SPIN(xb_ld(&bar[XB_TOPGEN]) == tg, bar);
            __builtin_amdgcn_fence(__ATOMIC_ACQUIRE, "agent");
            xb_add(&bar[XB_XGEN(b.x)], 1u);
            asm volatile("s_waitcnt vmcnt(0)" ::: "memory");
        } else {
            XB_SPIN(xb_ld(&bar[XB_XGEN(b.x)]) == gen, bar);
            __builtin_amdgcn_fence(__ATOMIC_ACQUIRE, "agent");
            asm volatile("s_waitcnt vmcnt(0)" ::: "memory");
        }
    }
    __syncthreads();
}

struct Args { const float* in[24]; float* out; unsigned char* ws; int ph_lo, ph_hi, li, pad; };

__device__ __forceinline__ int launder_idx(int i) { asm volatile("" : "+s"(i)); return i; }
__device__ __forceinline__ float wave_sum(float v) {
#pragma unroll
    for (int o = 1; o < 64; o <<= 1) v += __shfl_xor(v, o);
    return v;
}

__device__ __forceinline__ void p0_transpose_item(const float* W, int ldw, int src_col0, int K, bf16* WT, int dst_row0, LAS float* scr, int kb, int lane) {
    const int k0 = 64 * kb;
#pragma unroll 8
    for (int i = 0; i < 32; ++i) { const int kk = 2 * i + (lane >> 5); scr[kk * 33 + (lane & 31)] = W[(size_t)(k0 + kk) * ldw + src_col0 + (lane & 31)]; }
    LDS_WAIT(); asm volatile("" ::: "memory");
    const int c = lane & 7;
#pragma unroll
    for (int j = 0; j < 4; ++j) { const int n = (lane >> 3) + 8 * j; const LAS float* s = scr + (8 * c) * 33 + n;
        v4u o; o.x = pk2(s[0 * 33], s[1 * 33]); o.y = pk2(s[2 * 33], s[3 * 33]); o.z = pk2(s[4 * 33], s[5 * 33]); o.w = pk2(s[6 * 33], s[7 * 33]);
        *(GAS v4u*)(WT + (size_t)(dst_row0 + n) * K + k0 + 8 * c) = o; }
    LDS_WAIT(); asm volatile("" ::: "memory");
}
__device__ __forceinline__ void rms_row_to_bf16(const float* xrow, const float* gain, bf16* orow, int lane) {
    const GAS f32x4* xr = (const GAS f32x4*)xrow + lane; const GAS f32x4* gr = (const GAS f32x4*)gain + lane;
    f32x4 v[4]; float s = 0.f;
#pragma unroll
    for (int j = 0; j < 4; ++j) { v[j] = xr[64 * j]; s += (v[j].x * v[j].x + v[j].y * v[j].y) + (v[j].z * v[j].z + v[j].w * v[j].w); }
    const float rs = 1.0f / sqrtf(wave_sum(s) * (1.f / 1024.f) + EPS);
    GAS unsigned long long* o8 = (GAS unsigned long long*)orow + lane;
#pragma unroll
    for (int j = 0; j < 4; ++j) { const f32x4 g = gr[64 * j];
        o8[64 * j] = (unsigned long long)pk2(v[j].x * rs * g.x, v[j].y * rs * g.y) | ((unsigned long long)pk2(v[j].z * rs * g.z, v[j].w * rs * g.w) << 32); }
}
struct cpx { float r, i; };
__device__ __forceinline__ cpx cmul(cpx a, cpx b) { return cpx{a.r * b.r - a.i * b.i, a.r * b.i + a.i * b.r}; }

namespace gla {
constexpr int QP = 136, SP = 72;
constexpr int O_QI = 0, O_KI = O_QI + 64 * QP * 2, O_QE = O_KI + 64 * QP * 2, O_KST = O_QE + 64 * QP * 2, O_VT = O_KST + 128 * SP * 2, O_P = O_VT + 256 * SP * 2;
constexpr int O_DK = O_P + 64 * SP * 2, O_TOT = O_DK + 512, O_REF = O_TOT + 2048, O_SS = O_REF + 512, O_RS = O_SS + 2048, O_END = O_RS + 256;
static_assert(O_END <= RING_BYTES, "gla lds");
__device__ __forceinline__ int permk(int k) { const int k16 = k & 15; return (k & ~15) | (((k16 >> 2) & 1) << 3) | ((k16 >> 3) << 2) | (k16 & 3); }

template <bool WANT_O>
__device__ __forceinline__ void chunk(LAS unsigned char* lds, const bf16* __restrict__ Qg, const bf16* __restrict__ Kg, const bf16* __restrict__ LAg, const bf16* __restrict__ Vg,
                                      const bf16* __restrict__ SRg, const float* __restrict__ gn, bf16* __restrict__ OG, int m0, int h, f32x16 (&S)[4], int tid, int wid, int lane) {
    LAS bf16* QI = (LAS bf16*)(lds + O_QI); LAS bf16* KI = (LAS bf16*)(lds + O_KI); LAS bf16* QE = (LAS bf16*)(lds + O_QE);
    LAS bf16* KST = (LAS bf16*)(lds + O_KST); LAS bf16* VT = (LAS bf16*)(lds + O_VT); LAS bf16* P = (LAS bf16*)(lds + O_P);
    LAS float* DKs = (LAS float*)(lds + O_DK); LAS float* TOT = (LAS float*)(lds + O_TOT); LAS float* REF = (LAS float*)(lds + O_REF);
    LAS float* SS = (LAS float*)(lds + O_SS); LAS float* RS = (LAS float*)(lds + O_RS);
    const int kc = tid & 127, tq = tid >> 7;
    float c16[16], kv[16], qv[16];
    {
        const size_t gofs = (size_t)(m0 + 16 * tq) * GKEY + h * DKH + kc;
        float run = 0.f;
#pragma unroll
        for (int i = 0; i < 16; ++i) { run += bf2f(LAg[gofs + (size_t)i * GKEY]); c16[i] = run; kv[i] = bf2f(Kg[gofs + (size_t)i * GKEY]); if (WANT_O) qv[i] = bf2f(Qg[gofs + (size_t)i * GKEY]); }
        TOT[tq * 128 + kc] = run; if (tq == 2) REF[kc] = c16[0];
    }
    const int vv = tid & 255, sh = tid >> 8;
    unsigned vpk[16];
    {
        const bf16* vp = Vg + (size_t)(m0 + 32 * sh) * GVAL + h * DVH + vv;
#pragma unroll
        for (int i = 0; i < 16; ++i) vpk[i] = (unsigned)vp[(size_t)(2 * i) * GVAL] | ((unsigned)vp[(size_t)(2 * i + 1) * GVAL] << 16);
    }
    LDS_WAIT(); __builtin_amdgcn_s_barrier(); asm volatile("" ::: "memory");
    {
        const float t0 = TOT[kc], t1 = TOT[128 + kc], t2 = TOT[256 + kc], t3 = TOT[384 + kc];
        const float off = tq == 0 ? 0.f : (tq == 1 ? t0 : (tq == 2 ? t0 + t1 : t0 + t1 + t2));
        const float blast = (t0 + t1) + (t2 + t3), bref = t0 + t1 + REF[kc];
        unsigned kst[8];
        const int pk = permk(kc);
#pragma unroll
        for (int i = 0; i < 16; i += 2) {
            const float b0 = off + c16[i], b1 = off + c16[i + 1];
            kst[i >> 1] = pk2(kv[i] * __expf(blast - b0), kv[i + 1] * __expf(blast - b1));
            if (WANT_O) {
                const int t = 16 * tq + i;
                QI[t * QP + kc] = (bf16)f2bf(qv[i] * __expf(b0 - bref)); QI[(t + 1) * QP + kc] = (bf16)f2bf(qv[i + 1] * __expf(b1 - bref));
                KI[t * QP + kc] = (bf16)f2bf(kv[i] * __expf(bref - b0)); KI[(t + 1) * QP + kc] = (bf16)f2bf(kv[i + 1] * __expf(bref - b1));
                QE[t * QP + pk] = (bf16)f2bf(qv[i] * __expf(b0));        QE[(t + 1) * QP + pk] = (bf16)f2bf(qv[i + 1] * __expf(b1));
            }
        }
        *(LAS v4u*)(KST + kc * SP + 16 * tq) = (v4u){kst[0], kst[1], kst[2], kst[3]};
        *(LAS v4u*)(KST + kc * SP + 16 * tq + 8) = (v4u){kst[4], kst[5], kst[6], kst[7]};
        if (tq == 0) DKs[kc] = __expf(blast);
#pragma unroll
        for (int q4 = 0; q4 < 4; ++q4) *(LAS v4u*)(VT + vv * SP + 32 * sh + 8 * q4) = (v4u){vpk[4 * q4], vpk[4 * q4 + 1], vpk[4 * q4 + 2], vpk[4 * q4 + 3]};
    }
    LDS_WAIT(); __builtin_amdgcn_s_barrier(); asm volatile("" ::: "memory");
    const int fr = lane & 15, fq = lane >> 4, r = lane & 31, hh = lane >> 5, v0 = 32 * wid;
    if (WANT_O) {
#pragma unroll
        for (int rep = 0; rep < 2; ++rep) {
            const int idx = wid + 8 * rep;
            if (idx < 10) {
                const int ti = idx >= 6 ? 3 : (idx >= 3 ? 2 : (idx >= 1 ? 1 : 0)), si = idx - (ti * (ti + 1)) / 2;
                pg8::f32x4 acc = (pg8::f32x4){0.f, 0.f, 0.f, 0.f};
#pragma unroll
                for (int ks = 0; ks < 4; ++ks) {
                    const bf16x8 a = *(const LAS bf16x8*)(QI + (16 * ti + fr) * QP + 32 * ks + 8 * fq);
                    const bf16x8 b = *(const LAS bf16x8*)(KI + (16 * si + fr) * QP + 32 * ks + 8 * fq);
                    acc = __builtin_amdgcn_mfma_f32_16x16x32_bf16(a, b, acc, 0, 0, 0);
                }
                const int s = 16 * si + fr;
#pragma unroll
                for (int rg = 0; rg < 4; ++rg) { const int t = 16 * ti + 4 * fq + rg; P[t * SP + s] = (bf16)f2bf(s <= t ? acc[rg] : 0.f); }
            }
        }
        LDS_WAIT(); __builtin_amdgcn_s_barrier(); asm volatile("" ::: "memory");
    }
    bf16x8 vf[4];
#pragma unroll
    for (int ks = 0; ks < 4; ++ks) vf[ks] = *(const LAS bf16x8*)(VT + (v0 + r) * SP + 16 * ks + 8 * hh);
    f32x16 o[2];
    if (WANT_O) {
#pragma unroll
        for (int tt = 0; tt < 2; ++tt) {
#pragma unroll
            for (int j = 0; j < 16; ++j) o[tt][j] = 0.f;
#pragma unroll
            for (int ks = 0; ks < 4; ++ks) if (tt == 1 || ks < 2) {
                const bf16x8 a = *(const LAS bf16x8*)(P + (32 * tt + r) * SP + 16 * ks + 8 * hh);
                o[tt] = __builtin_amdgcn_mfma_f32_32x32x16_bf16(a, vf[ks], o[tt], 0, 0, 0);
            }
        }
#pragma unroll
        for (int kt = 0; kt < 4; ++kt)
#pragma unroll
            for (int s2 = 0; s2 < 2; ++s2) {
                v4u bw; bw.x = pk2(S[kt][8 * s2 + 0], S[kt][8 * s2 + 1]); bw.y = pk2(S[kt][8 * s2 + 2], S[kt][8 * s2 + 3]);
                bw.z = pk2(S[kt][8 * s2 + 4], S[kt][8 * s2 + 5]); bw.w = pk2(S[kt][8 * s2 + 6], S[kt][8 * s2 + 7]);
                const bf16x8 bfr = __builtin_bit_cast(bf16x8, bw);
#pragma unroll
                for (int tt = 0; tt < 2; ++tt) {
                    const bf16x8 a = *(const LAS bf16x8*)(QE + (32 * tt + r) * QP + 32 * kt + 16 * s2 + 8 * hh);
                    o[tt] = __builtin_amdgcn_mfma_f32_32x32x16_bf16(a, bfr, o[tt], 0, 0, 0);
                }
            }
    }
#pragma unroll
    for (int kt = 0; kt < 4; ++kt) {
#pragma unroll
        for (int g4 = 0; g4 < 4; ++g4) { const f32x4 d4 = *(const LAS f32x4*)(DKs + 32 * kt + 8 * g4 + 4 * hh);
#pragma unroll
            for (int e = 0; e < 4; ++e) S[kt][4 * g4 + e] *= d4[e]; }
#pragma unroll
        for (int ks = 0; ks < 4; ++ks) {
            const bf16x8 a = *(const LAS bf16x8*)(KST + (32 * kt + r) * SP + 16 * ks + 8 * hh);
            S[kt] = __builtin_amdgcn_mfma_f32_32x32x16_bf16(a, vf[ks], S[kt], 0, 0, 0);
        }
    }
    if (WANT_O) {
#pragma unroll
        for (int tt = 0; tt < 2; ++tt)
#pragma unroll
            for (int j = 0; j < 16; ++j) {
                float q = o[tt][j] * o[tt][j];
                q += __shfl_xor(q, 1); q += __shfl_xor(q, 2); q += __shfl_xor(q, 4); q += __shfl_xor(q, 8); q += __shfl_xor(q, 16);
                if (r == 0) SS[wid * 64 + 32 * tt + (j & 3) + 8 * (j >> 2) + 4 * hh] = q;
            }
        LDS_WAIT(); __builtin_amdgcn_s_barrier(); asm volatile("" ::: "memory");
        if (tid < 64) { float s = 0.f;
#pragma unroll
            for (int w = 0; w < 8; ++w) s += SS[w * 64 + tid];
            RS[tid] = 1.0f / sqrtf(s * (1.f / 256.f) + EPS); }
        LDS_WAIT(); __builtin_amdgcn_s_barrier(); asm volatile("" ::: "memory");
        const float gv = gn[h * DVH + v0 + r];
#pragma unroll
        for (int tt = 0; tt < 2; ++tt)
#pragma unroll
            for (int g4 = 0; g4 < 4; ++g4) { const f32x4 rs4 = *(const LAS f32x4*)(RS + 32 * tt + 8 * g4 + 4 * hh);
#pragma unroll
                for (int e = 0; e < 4; ++e) { const int t = 32 * tt + 8 * g4 + 4 * hh + e; const size_t off = (size_t)(m0 + t) * GVAL + h * DVH + v0 + r;
                    OG[off] = (bf16)f2bf(o[tt][4 * g4 + e] * rs4[e] * gv * bf2f(SRg[off])); } }
    } else {
        LDS_WAIT(); __builtin_amdgcn_s_barrier(); asm volatile("" ::: "memory");
    }
}

__device__ __forceinline__ void meta_state(LAS unsigned char* lds, const float* KM, const float* VM, const float* AL, const float* wgu, const float* bgate, int h, f32x16 (&S)[4], int tid, int wid, int lane) {
    LAS float* LM = (LAS float*)lds;
    LAS float* KS = (LAS float*)(lds + 8192);
    const int kc = tid & 127, part = tid >> 7;
#pragma unroll
    for (int i = 0; i < 4; ++i) { const int s = 4 * part + i; float z = bgate[h * DKH + kc];
#pragma unroll
        for (int rr = 0; rr < RANK; ++rr) z += AL[s * RANK + rr] * wgu[rr * GKEY + h * DKH + kc];
        LM[s * 128 + kc] = pg8::logsigf_(z) * 0.0625f; }
    LDS_WAIT(); __syncthreads();
    if (part == 0) { float suf = 0.f;
        for (int s = 15; s >= 0; --s) { KS[s * 128 + kc] = KM[s * GKEY + h * DKH + kc] * __expf(suf); suf += LM[s * 128 + kc]; } }
    LDS_WAIT(); __syncthreads();
    const int r = lane & 31, hh = lane >> 5, v0 = 32 * wid;
    float vm[16];
#pragma unroll
    for (int s = 0; s < 16; ++s) vm[s] = VM[s * GVAL + h * DVH + v0 + r];
#pragma unroll
    for (int kt = 0; kt < 4; ++kt)
#pragma unroll
        for (int j = 0; j < 16; ++j) { const int k = 32 * kt + (j & 3) + 8 * (j >> 2) + 4 * hh; float a = 0.f;
#pragma unroll
            for (int s = 0; s < 16; ++s) a += KS[s * 128 + k] * vm[s];
            S[kt][j] = a; }
    LDS_WAIT(); __syncthreads();
}
}

__global__ void __launch_bounds__(NWAVES * 64, 2) fwd_kernel(Args args) {
    extern __shared__ __attribute__((aligned(16))) unsigned char lds_raw[];
    LAS unsigned char* lds = (LAS unsigned char*)lds_raw;
    volatile LAS unsigned* MISC = (volatile LAS unsigned*)(lds + MISC_OFF);
    const int G = gridDim.x; const int bx = blockIdx.x; const int vcu = (G % 8 == 0) ? (bx % 8) * (G / 8) + bx / 8 : bx;
    const int wave = __builtin_amdgcn_readfirstlane((int)threadIdx.x >> 6);
#define LANE_ID() ((int)__builtin_amdgcn_mbcnt_hi(~0u, __builtin_amdgcn_mbcnt_lo(~0u, 0u)))
#define T0() (wave == 0 && LANE_ID() == 0)
#define PHASE_IDS() int lane_ = LANE_ID(); asm volatile("" : "+v"(lane_)); const int lane = lane_, tid = wave * 64 + lane; const int gw = vcu * NWAVES + wave, NGW = G * NWAVES; (void)tid; (void)gw; (void)NGW
    unsigned char* ws = args.ws;
    unsigned* ctl = (unsigned*)(ws + WS_CTL);
#define INP(i) (args.in[launder_idx(i)])
#define x_in INP(0)
#define meta_tokens INP(1)
#define g_mix_pre INP(2)
#define w_in INP(3)
#define w_gate_up INP(4)
#define b_gate INP(5)
#define gla_norm_g INP(6)
#define w_o_gla INP(7)
#define a_re INP(8)
#define a_im INP(9)
#define log_step INP(10)
#define b_re INP(11)
#define b_im INP(12)
#define c_re INP(13)
#define c_im INP(14)
#define d_skip INP(15)
#define w_glu INP(16)
#define b_glu INP(17)
#define w_out INP(18)
#define g_mix_post INP(19)
#define g_ffn_pre INP(20)
#define w_ff1 INP(21)
#define w_ff2 INP(22)
#define g_ffn_post INP(23)
    float* out = args.out;
    bf16* WT_in = (bf16*)(ws + WS_WIN); bf16* WT_o = (bf16*)(ws + WS_WO); bf16* WT_glu = (bf16*)(ws + WS_WGLU); bf16* WT_out = (bf16*)(ws + WS_WOUT);
    bf16* WT_ff1 = (bf16*)(ws + WS_WFF1); bf16* WT_ff2 = (bf16*)(ws + WS_WFF2); bf16* TZ = (bf16*)(ws + WS_TZ); bf16* MS = (bf16*)(ws + WS_MS);
    bf16* XN = (bf16*)(ws + WS_XN); bf16* OG = XN; bf16* HN = XN;
    bf16* Qb = (bf16*)(ws + WS_Q); bf16* Kb = (bf16*)(ws + WS_K); bf16* Vb = (bf16*)(ws + WS_V); bf16* SR = (bf16*)(ws + WS_SR); bf16* LAb = (bf16*)(ws + WS_LA); bf16* UH = (bf16*)(ws + WS_UH);
    bf16* GS = (bf16*)(ws + WS_GS); bf16* YG = (bf16*)(ws + WS_YG); bf16* MIX = (bf16*)(ws + WS_MIX); float* T1 = (float*)(ws + WS_T);
    bf16* F1 = (bf16*)(ws + WS_F1); float* T2 = (float*)(ws + WS_T2);
    bf16* SZG = (bf16*)out; bf16* SZS = (bf16*)out + (size_t)M * D;
    float* KM = (float*)(ws + WS_SMALL + SM_KM); float* VM = (float*)(ws + WS_SMALL + SM_VM); float* AL = (float*)(ws + WS_SMALL + SM_AL);
    float* UM = (float*)(ws + WS_SMALL + SM_UM); float* L16 = (float*)(ws + WS_SMALL + SM_L16);

    for (int u = wave * 64 + LANE_ID(); u < (LDS_BYTES - LDSCTL_OFF) / 4; u += NWAVES * 64) ((LAS unsigned*)(lds + LDSCTL_OFF))[u] = 0u;
    __syncthreads();
    XcdBarrier bar; bar.bar = ctl + CW_BAR; bar.x = 0; bar.st = nullptr;
    if (N_LAUNCHES == 1) bar = xcd_barrier_post(ctl + CW_BAR, MISC + 8, T0());
    const int lo = args.ph_lo, hi = args.ph_hi;
#define IN(k) (lo <= (k) && (k) < hi)
#define SEAM(k) do { if (IN(k) && IN((k) + 1)) xcd_barrier(bar, T0()); } while (0)

    if (IN(0)) {
        PHASE_IDS();
        if (vcu < 41) {
            LAS float* XNM = (LAS float*)lds;
            LAS float* PART = (LAS float*)(lds + 65536);
#pragma unroll
            for (int rr = 0; rr < 2; ++rr) { const int row = 2 * wave + rr;
                const GAS f32x4* xr = (const GAS f32x4*)(meta_tokens + (size_t)row * D) + lane; const GAS f32x4* gr = (const GAS f32x4*)g_mix_pre + lane;
                f32x4 v[4]; float s = 0.f;
#pragma unroll
                for (int j = 0; j < 4; ++j) { v[j] = xr[64 * j]; s += (v[j].x * v[j].x + v[j].y * v[j].y) + (v[j].z * v[j].z + v[j].w * v[j].w); }
                const float rs = 1.0f / sqrtf(wave_sum(s) * (1.f / 1024.f) + EPS);
#pragma unroll
                for (int j = 0; j < 4; ++j) { const f32x4 g = gr[64 * j]; *(LAS f32x4*)(XNM + row * 1024 + 4 * lane + 256 * j) = (f32x4){v[j].x * rs * g.x, v[j].y * rs * g.y, v[j].z * rs * g.z, v[j].w * rs * g.w}; } }
            LDS_WAIT(); __syncthreads();
            const int it = vcu; int src, ncol; float* dst; int dld, dcol;
            if (it < 8)       { src = 512 + 64 * it;          ncol = 64; dst = KM; dld = 512;  dcol = 64 * it; }
            else if (it < 24) { src = 1024 + 64 * (it - 8);   ncol = 64; dst = VM; dld = 1024; dcol = 64 * (it - 8); }
            else if (it == 24){ src = SRC_A;                  ncol = 16; dst = AL; dld = 16;   dcol = 0; }
            else              { src = SRC_U + 64 * (it - 25); ncol = 64; dst = UM; dld = 1024; dcol = 64 * (it - 25); }
            float acc[16];
#pragma unroll
            for (int rr = 0; rr < 16; ++rr) acc[rr] = 0.f;
            const bool colok = lane < ncol;
            for (int k4 = 0; k4 < 32; ++k4) { const int k = 128 * wave + 4 * k4;
                float wv[4];
#pragma unroll
                for (int e = 0; e < 4; ++e) wv[e] = colok ? w_in[(size_t)(k + e) * IN_W + src + lane] : 0.f;
#pragma unroll
                for (int rr = 0; rr < 16; ++rr) { const f32x4 xv = *(const LAS f32x4*)(XNM + rr * 1024 + k); acc[rr] += (xv.x * wv[0] + xv.y * wv[1]) + (xv.z * wv[2] + xv.w * wv[3]); } }
#pragma unroll
            for (int rr = 0; rr < 16; ++rr) PART[(wave * 16 + rr) * 64 + lane] = acc[rr];
            LDS_WAIT(); __syncthreads();
#pragma unroll
            for (int e = 0; e < 2; ++e) { const int idx = tid + 512 * e, rr = idx >> 6, col = idx & 63; float s = 0.f;
#pragma unroll
                for (int w = 0; w < 8; ++w) s += PART[(w * 16 + rr) * 64 + col];
                if (col < ncol) dst[rr * dld + dcol + col] = s; }
            LDS_WAIT(); __syncthreads();
        }
        LAS float* scr = (LAS float*)(lds + wave * 16384);
        constexpr int I_IN = 192 * 16, I_O = 32 * 16, I_GLU = 64 * 16, I_OUT = 32 * 16, I_FF1 = 128 * 16, I_FF2 = 32 * 64;
        constexpr int I_WA = 8 * 128, I_SSM = 64 * 16, I_XN = M;
        constexpr int NITEMS = I_IN + I_O + I_GLU + I_OUT + I_FF1 + I_FF2 + I_WA + I_SSM + I_XN;
        for (int it = gw; it < NITEMS; it += NGW) {
            int r = it;
            if (r < I_IN) { const int rb = r >> 4, kb = r & 15, d0 = 32 * rb; p0_transpose_item(w_in, IN_W, d0 < 3072 ? d0 : d0 + 16, D, WT_in, d0, scr, kb, lane); continue; } r -= I_IN;
            if (r < I_O) { const int rb = r >> 4, kb = r & 15; p0_transpose_item(w_o_gla, D, 32 * rb, GVAL, WT_o, 32 * rb, scr, kb, lane); continue; } r -= I_O;
            if (r < I_GLU) { const int rb = r >> 4, kb = r & 15, d0 = 32 * rb, pn = d0 >> 8, wi = d0 & 255;
                p0_transpose_item(w_glu, 2 * D, wi < 128 ? 128 * pn + wi : 1024 + 128 * pn + (wi - 128), D, WT_glu, d0, scr, kb, lane); continue; } r -= I_GLU;
            if (r < I_OUT) { const int rb = r >> 4, kb = r & 15; p0_transpose_item(w_out, D, 32 * rb, D, WT_out, 32 * rb, scr, kb, lane); continue; } r -= I_OUT;
            if (r < I_FF1) { const int rb = r >> 4, kb = r & 15; p0_transpose_item(w_ff1, FF, 32 * rb, D, WT_ff1, 32 * rb, scr, kb, lane); continue; } r -= I_FF1;
            if (r < I_FF2) { const int rb = r >> 6, kb = r & 63; p0_transpose_item(w_ff2, D, 32 * rb, FF, WT_ff2, 32 * rb, scr, kb, lane); continue; } r -= I_FF2;
            if (r < I_WA) {
                const int nb = r >> 7, kb = r & 127, n = 64 * nb + lane;
                float wg[16];
#pragma unroll
                for (int rr = 0; rr < 16; ++rr) wg[rr] = w_gate_up[rr * GKEY + n];
                float o8[8];
#pragma unroll
                for (int e = 0; e < 8; ++e) { const float* wr_ = w_in + (size_t)(8 * kb + e) * IN_W + SRC_A; float s = 0.f;
#pragma unroll
                    for (int rr = 0; rr < 16; ++rr) s += wr_[rr] * wg[rr];
                    o8[e] = s; }
                *(GAS v4u*)(WT_in + (size_t)(6144 + n) * D + 8 * kb) = (v4u){pk2(o8[0], o8[1]), pk2(o8[2], o8[3]), pk2(o8[4], o8[5]), pk2(o8[6], o8[7])};
                continue; } r -= I_WA;
            if (r < I_SSM) {
                const int g = r >> 4, d = r & 15, n = lane;
                LAS float* BBr = scr;
                LAS float* BBi = scr + 1024;
                LAS float* LDr = scr + 2048;
                LAS float* LDi = scr + 2112;
                const float ar = a_re[g * SN + n], ai = a_im[g * SN + n], dt = expf(log_step[g]);
                const float mag = expf(ar * dt), lr = mag * cosf(ai * dt), li = mag * sinf(ai * dt);
                const float zr = lr - 1.0f, zi = li, den = ar * ar + ai * ai, fre = (zr * ar + zi * ai) / den, fim = (zi * ar - zr * ai) / den;
                float bbr[16], bbi[16];
#pragma unroll
                for (int j = 0; j < 16; ++j) { const float br = b_re[(g * SN + n) * SHG + j], bi = b_im[(g * SN + n) * SHG + j];
                    bbr[j] = fre * br - fim * bi; bbi[j] = fre * bi + fim * br; BBr[n * 16 + j] = bbr[j]; BBi[n * 16 + j] = bbi[j]; }
                auto powl = [&](int p) { const float mg = expf((float)p * (ar * dt)), an = (float)p * (ai * dt); return cpx{mg * cosf(an), mg * sinf(an)}; };
                const cpx wd = powl(d), wd1 = powl(d + 1), w15 = powl(15 - d);
                LDr[n] = wd.r; LDi[n] = wd.i;
                LDS_WAIT(); asm volatile("" ::: "memory");
                {
                    const int i = lane >> 2, j0 = (lane & 3) * 4; float a4[4] = {0.f, 0.f, 0.f, 0.f};
                    for (int nn = 0; nn < SN; ++nn) { const cpx c = cpx{c_re[(g * SHG + i) * SN + nn], c_im[(g * SHG + i) * SN + nn]}; const cpx cw = cmul(c, cpx{LDr[nn], LDi[nn]});
#pragma unroll
                        for (int e = 0; e < 4; ++e) a4[e] += cw.r * BBr[nn * 16 + j0 + e] - cw.i * BBi[nn * 16 + j0 + e]; }
                    if (d == 0) {
#pragma unroll
                        for (int e = 0; e < 4; ++e) if (i == j0 + e) a4[e] += d_skip[g * SHG + i]; }
                    const v2u val = (v2u){pk2(a4[0], a4[1]), pk2(a4[2], a4[3])}, zero = (v2u){0u, 0u};
                    for (int t = d; t < 16; ++t) *(GAS v2u*)(TZ + (size_t)(g * 256 + 16 * t + i) * 384 + 16 * (t - d) + j0) = val;
                    if (d >= 1) for (int t = 0; t + d < 16; ++t) *(GAS v2u*)(TZ + (size_t)(g * 256 + 16 * t + i) * 384 + 16 * (t + d) + j0) = zero;
                }
                for (int i = 0; i < 16; ++i) { const cpx c = cpx{c_re[(g * SHG + i) * SN + n], c_im[(g * SHG + i) * SN + n]}; const cpx cl = cmul(c, wd1);
                    TZ[(size_t)(g * 256 + 16 * d + i) * 384 + 256 + n] = (bf16)f2bf(cl.r); TZ[(size_t)(g * 256 + 16 * d + i) * 384 + 320 + n] = (bf16)f2bf(-cl.i); }
                { unsigned pr[8], pi[8];
#pragma unroll
                    for (int j = 0; j < 16; j += 2) { const cpx v0 = cmul(w15, cpx{bbr[j], bbi[j]}), v1 = cmul(w15, cpx{bbr[j + 1], bbi[j + 1]}); pr[j >> 1] = pk2(v0.r, v1.r); pi[j >> 1] = pk2(v0.i, v1.i); }
                    GAS v4u* p0 = (GAS v4u*)(MS + (size_t)(g * 128 + n) * 256 + 16 * d); p0[0] = (v4u){pr[0], pr[1], pr[2], pr[3]}; p0[1] = (v4u){pr[4], pr[5], pr[6], pr[7]};
                    GAS v4u* p1 = (GAS v4u*)(MS + (size_t)(g * 128 + 64 + n) * 256 + 16 * d); p1[0] = (v4u){pi[0], pi[1], pi[2], pi[3]}; p1[1] = (v4u){pi[4], pi[5], pi[6], pi[7]}; }
                if (d == 0) { const cpx w16 = powl(16); L16[(g * SN + n) * 2] = w16.r; L16[(g * SN + n) * 2 + 1] = w16.i; }
                LDS_WAIT(); asm volatile("" ::: "memory");
                continue; } r -= I_SSM;
            rms_row_to_bf16(x_in + (size_t)r * D, g_mix_pre, XN + (size_t)r * D, lane);
        }
    }
    SEAM(0);

    if (IN(1)) {
        pg8::Gemm g{XN, WT_in, D, D, D, 256}; pg8::StaticOrder S; S.init(M, NIN, G, bx);
        pg8::EpiIn E{Qb, Kb, Vb, SR, UH, SZG, SZS, LAb, b_gate};
        pg8::gemm_phase<pg8::EpiIn, pg8::StaticOrder, true>(lds, g, S, E, wave);
    }
    SEAM(1);

    if (IN(2)) {
        pg8::Gemm g{UH, MS, 384, 256, 256, 128}; pg8::GroupOrder S{G, bx};
        pg8::EpiE E{UH};
        pg8::gemm_phase<pg8::EpiE, pg8::GroupOrder, true>(lds, g, S, E, wave);
    }
    SEAM(2);

    if (IN(3)) {
        PHASE_IDS();
        if (wave < 2) {
            const int p = 2 * vcu + wave;
            if (p < BATCH * SG) {
                const int b = p >> 6, g = p & 63, n = lane;
                float hr = 0.f, hi_ = 0.f;
                {
                    const bf16* m0p = MS + (size_t)(g * 128 + n) * 256; const bf16* m1p = MS + (size_t)(g * 128 + 64 + n) * 256;
                    for (int k = 0; k < 256; ++k) { const float uv = UM[(k >> 4) * D + g * SHG + (k & 15)]; hr += bf2f(m0p[k]) * uv; hi_ += bf2f(m1p[k]) * uv; }
                }
                const float lr = L16[(g * SN + n) * 2], li = L16[(g * SN + n) * 2 + 1];
                bf16* base = UH + (size_t)(g * 2048 + b * 256) * 384 + 256 + n;
                for (int c0 = 0; c0 < 256; c0 += 8) {
                    float er[8], ei[8];
#pragma unroll
                    for (int j = 0; j < 8; ++j) { er[j] = bf2f(base[(size_t)(c0 + j) * 384]); ei[j] = bf2f(base[(size_t)(c0 + j) * 384 + 64]); }
#pragma unroll
                    for (int j = 0; j < 8; ++j) { base[(size_t)(c0 + j) * 384] = (bf16)f2bf(hr); base[(size_t)(c0 + j) * 384 + 64] = (bf16)f2bf(hi_);
                        const float nr = lr * hr - li * hi_ + er[j], ni = lr * hi_ + li * hr + ei[j]; hr = nr; hi_ = ni; }
                }
            }
        }
        __syncthreads();
        if (vcu < BATCH * NH) {
            const int b = vcu >> 2, h = vcu & 3;
            for (int i = tid; i < 64 * gla::SP / 2; i += 512) ((LAS unsigned*)(lds + gla::O_P))[i] = 0u;
            f32x16 S[4];
            gla::meta_state(lds, KM, VM, AL, w_gate_up, b_gate, h, S, tid, wave, lane);
            for (int c = 0; c < SEQ / 64; ++c)
                gla::chunk<true>(lds, Qb, Kb, LAb, Vb, SR, gla_norm_g, OG, b * SEQ + 64 * c, h, S, tid, wave, lane);
        }
    }
    SEAM(3);

    if (IN(4)) {
        { pg8::Gemm g{UH, TZ, 384, 384, 384, 256}; pg8::GroupOrder S{G, bx}; pg8::EpiS E{GS};
          pg8::gemm_phase<pg8::EpiS, pg8::GroupOrder, true>(lds, g, S, E, wave); }
        { pg8::Gemm g{OG, WT_o, D, D, D, 256}; pg8::StaticOrder S; S.init(M, D, G, bx); pg8::EpiYG E{SZG, YG};
          pg8::gemm_phase<pg8::EpiYG, pg8::StaticOrder, true>(lds, g, S, E, wave); }
    }
    SEAM(4);

    if (IN(5)) {
        pg8::Gemm g{GS, WT_glu, D, D, D, 256}; pg8::StaticOrder S; S.init(M, 2 * D, G, bx); pg8::EpiGlu E{YG, SZS, MIX, b_glu};
        pg8::gemm_phase<pg8::EpiGlu, pg8::StaticOrder, true>(lds, g, S, E, wave);
    }
    SEAM(5);

    if (IN(6)) {
        pg8::Gemm g{MIX, WT_out, D, D, D, 256}; pg8::StaticOrder S; S.init(M, D, G, bx); pg8::EpiF32 E{T1, D};
        pg8::gemm_phase<pg8::EpiF32, pg8::StaticOrder, true>(lds, g, S, E, wave);
    }
    SEAM(6);

    if (IN(7)) {
        PHASE_IDS();
        for (int m = gw; m < M; m += NGW) {
            const GAS f32x4* tr = (const GAS f32x4*)(T1 + (size_t)m * D) + lane; const GAS f32x4* xr = (const GAS f32x4*)(x_in + (size_t)m * D) + lane;
            const GAS f32x4* g1 = (const GAS f32x4*)g_mix_post + lane; const GAS f32x4* g2 = (const GAS f32x4*)g_ffn_pre + lane;
            f32x4 v[4]; float s = 0.f;
#pragma unroll
            for (int j = 0; j < 4; ++j) { v[j] = tr[64 * j]; s += (v[j].x * v[j].x + v[j].y * v[j].y) + (v[j].z * v[j].z + v[j].w * v[j].w); }
            const float rs = 1.0f / sqrtf(wave_sum(s) * (1.f / 1024.f) + EPS); float s2 = 0.f;
#pragma unroll
            for (int j = 0; j < 4; ++j) { const f32x4 g = g1[64 * j], xv = xr[64 * j]; v[j] = (f32x4){xv.x + v[j].x * rs * g.x, xv.y + v[j].y * rs * g.y, xv.z + v[j].z * rs * g.z, xv.w + v[j].w * rs * g.w};
                s2 += (v[j].x * v[j].x + v[j].y * v[j].y) + (v[j].z * v[j].z + v[j].w * v[j].w);
                *((GAS f32x4*)(out + (size_t)m * D) + lane + 64 * j) = v[j]; }
            const float rs2 = 1.0f / sqrtf(wave_sum(s2) * (1.f / 1024.f) + EPS);
            GAS unsigned long long* o8 = (GAS unsigned long long*)(HN + (size_t)m * D) + lane;
#pragma unroll
            for (int j = 0; j < 4; ++j) { const f32x4 g = g2[64 * j];
                o8[64 * j] = (unsigned long long)pk2(v[j].x * rs2 * g.x, v[j].y * rs2 * g.y) | ((unsigned long long)pk2(v[j].z * rs2 * g.z, v[j].w * rs2 * g.w) << 32); }
        }
    }
    SEAM(7);

    if (IN(8)) {
        pg8::Gemm g{HN, WT_ff1, D, D, D, 256}; pg8::StaticOrder S; S.init(M, FF, G, bx); pg8::EpiRelu2 E{F1, FF};
        pg8::gemm_phase<pg8::EpiRelu2, pg8::StaticOrder, true>(lds, g, S, E, wave);
    }
    SEAM(8);

    if (IN(9)) {
        pg8::Gemm g{F1, WT_ff2, FF, FF, FF, 256}; pg8::StaticOrder S; S.init(M, D, G, bx); pg8::EpiF32 E{T2, D};
        pg8::gemm_phase<pg8::EpiF32, pg8::StaticOrder, true>(lds, g, S, E, wave);
    }
    SEAM(9);

    if (IN(10)) {
        PHASE_IDS();
        for (int m = gw; m < M; m += NGW) {
            const GAS f32x4* tr = (const GAS f32x4*)(T2 + (size_t)m * D) + lane; GAS f32x4* orow = (GAS f32x4*)(out + (size_t)m * D) + lane;
            const GAS f32x4* g1 = (const GAS f32x4*)g_ffn_post + lane;
            f32x4 v[4]; float s = 0.f;
#pragma unroll
            for (int j = 0; j < 4; ++j) { v[j] = tr[64 * j]; s += (v[j].x * v[j].x + v[j].y * v[j].y) + (v[j].z * v[j].z + v[j].w * v[j].w); }
            const float rs = 1.0f / sqrtf(wave_sum(s) * (1.f / 1024.f) + EPS);
#pragma unroll
            for (int j = 0; j < 4; ++j) { const f32x4 g = g1[64 * j], hv = orow[64 * j];
                orow[64 * j] = (f32x4){hv.x + v[j].x * rs * g.x, hv.y + v[j].y * rs * g.y, hv.z + v[j].z * rs * g.z, hv.w + v[j].w * rs * g.w}; }
        }
    }
#undef IN
#undef SEAM
#undef x_in
#undef meta_tokens
#undef g_mix_pre
#undef w_in
#undef w_gate_up
#undef b_gate
#undef gla_norm_g
#undef w_o_gla
#undef a_re
#undef a_im
#undef log_step
#undef b_re
#undef b_im
#undef c_re
#undef c_im
#undef d_skip
#undef w_glu
#undef b_glu
#undef w_out
#undef g_mix_post
#undef g_ffn_pre
#undef w_ff1
#undef w_ff2
#undef g_ffn_post
}

extern "C" void kernel_launch(void* const* d_in, const int* in_sizes, int n_in, void* d_out, int out_size, void* d_ws, size_t ws_size, hipStream_t stream) {
    static int grid = 0;
    if (grid == 0) {
        if (n_in != 24 || in_sizes[0] != M * D || out_size != M * D || ws_size < WS_END) { fprintf(stderr, "kernel_launch: unexpected shapes (n_in %d, in0 %d, out %d, ws %zu)\n", n_in, n_in > 0 ? in_sizes[0] : -1, out_size, ws_size); grid = -1; return; }
        int dev = 0, cus = 0;
        if (hipGetDevice(&dev) != hipSuccess || hipDeviceGetAttribute(&cus, hipDeviceAttributeMultiprocessorCount, dev) != hipSuccess) { grid = -1; return; }
        if (hipFuncSetAttribute((const void*)fwd_kernel, hipFuncAttributeMaxDynamicSharedMemorySize, LDS_BYTES) != hipSuccess) { fprintf(stderr, "kernel_launch: hipFuncSetAttribute failed\n"); grid = -1; return; }
        int per_cu = 0;
        if (hipOccupancyMaxActiveBlocksPerMultiprocessor(&per_cu, (const void*)fwd_kernel, NWAVES * 64, LDS_BYTES) != hipSuccess || per_cu < 1) fprintf(stderr, "kernel_launch: occupancy query says %d\n", per_cu);
        (void)hipGetLastError();
        grid = cus;
    }
    if (grid < 0) return;
    if (hipMemsetAsync((char*)d_ws + WS_CTL, 0, CTL_ZERO_BYTES, stream) != hipSuccess) return;
    Args a{};
    for (int i = 0; i < 24; ++i) a.in[i] = (const float*)d_in[i];
    a.out = (float*)d_out; a.ws = (unsigned char*)d_ws;
    if (N_LAUNCHES == 1) {
        a.ph_lo = 0; a.ph_hi = N_PHASES; a.li = 0;
        hipLaunchKernelGGL(fwd_kernel, dim3(grid), dim3(NWAVES * 64), LDS_BYTES, stream, a);
    } else {
        for (int li = 0; li < N_PHASES; ++li) { a.ph_lo = li; a.ph_hi = li + 1; a.li = li;
            hipLaunchKernelGGL(fwd_kernel, dim3(grid), dim3(NWAVES * 64), LDS_BYTES, stream, a); }
    }
}
```

```cpp
#include <hip/hip_runtime.h>
#include <cstdio>
#include <cstdint>

#ifndef PROBE_REP_MASK
#define PROBE_REP_MASK 0
#endif
#ifndef MK_N_LAUNCHES
#define MK_N_LAUNCHES 1
#endif

namespace pg8 {
#define PG8_LAS __attribute__((address_space(3)))
typedef unsigned short bf16_t;
typedef short bf16x8 __attribute__((ext_vector_type(8)));
typedef float f32x4 __attribute__((ext_vector_type(4)));
typedef float f32x2 __attribute__((ext_vector_type(2)));
typedef unsigned u32x4 __attribute__((ext_vector_type(4)));
constexpr int BM = 256, BK = 64, HALF = 128, HTB = HALF * BK * 2, STAGE_BYTES = 8 * HTB, NXCD = 8, WGM = 8;

__host__ __device__ __forceinline__ int lds_byte(int r, int c) { const int st = (r >> 4) * 2 + (c >> 5), rr = r & 15, cc = c & 31, ob = rr * 64 + cc * 2; return st * 1024 + (ob ^ (((ob >> 9) & 1) << 5)); }
__host__ __device__ __forceinline__ void stage_rc(int b, int& R, int& C) { const int st = b / 1024, sb = b % 1024, swz = sb ^ (((sb >> 9) & 1) << 5); R = (st >> 1) * 16 + swz / 64; C = (st & 1) * 32 + (swz % 64) / 2; }
__host__ __device__ __forceinline__ int perm32(int rho) { const int n = rho >> 4, i = rho & 15; return 8 * (i >> 2) + 4 * n + (i & 3); }

struct Unit { int pm, pn; };
struct Gemm { const bf16_t* A; const bf16_t* Bt; int lda, ldb, K, tstepB_rows; };

struct StaticOrder {
    int nM, nN, nwg, G, c;
    __host__ __device__ void init(int M, int N, int G_, int c_) { nM = M / BM; nN = N / BM; nwg = nM * nN; G = G_; c = c_; }
    __host__ __device__ bool next(int i, Unit& u) const {
        const long L = (long)i * G + c; if (L >= nwg) return false;
        int wgid = (int)L; { const int q = nwg / NXCD, r = nwg % NXCD, xcd = wgid % NXCD, off = wgid / NXCD; wgid = (xcd < r ? xcd * (q + 1) : r * (q + 1) + (xcd - r) * q) + off; }
        const int nig = WGM * nN, gid = wgid / nig, fm = gid * WGM, gsz = (nM - fm) < WGM ? (nM - fm) : WGM;
        u.pm = fm + ((wgid % nig) % gsz); u.pn = (wgid % nig) / gsz; return true;
    }
};
struct GroupOrder {
    int G, c;
    __host__ __device__ bool next(int i, Unit& u) const { const int L = i * G + c; if (L >= 512) return false; u.pm = L; u.pn = L >> 3; return true; }
};

__device__ __forceinline__ unsigned cvt_pk_bf16(float lo, float hi) { unsigned r; asm volatile("v_cvt_pk_bf16_f32 %0, %1, %2" : "=v"(r) : "v"(lo), "v"(hi)); return r; }
__device__ __forceinline__ float bflo(unsigned w) { return __uint_as_float(w << 16); }
__device__ __forceinline__ float bfhi(unsigned w) { return __uint_as_float(w & 0xffff0000u); }
__device__ __forceinline__ float sigmoidf_(float x) { return __builtin_amdgcn_rcpf(1.0f + __expf(-x)); }
__device__ __forceinline__ float logsigf_(float x) { return fminf(x, 0.f) - log1pf(__expf(-fabsf(x))); }
__device__ __forceinline__ float gelu_tanh(float x) { const float z = 0.7978845608028654f * (x + 0.044715f * x * x * x); return x * __builtin_amdgcn_rcpf(1.0f + __expf(-2.0f * z)); }
__device__ __forceinline__ u32x4 pack8(const f32x4& a, const f32x4& b) { u32x4 w; w.x = cvt_pk_bf16(a[0], a[1]); w.y = cvt_pk_bf16(a[2], a[3]); w.z = cvt_pk_bf16(b[0], b[1]); w.w = cvt_pk_bf16(b[2], b[3]); return w; }

struct EpiF32 {
    static constexpr bool PERM = false;
    float* C; int ldc;
    __device__ __forceinline__ void operator()(const f32x4 (&acc)[2][2][4][2], const Unit& u, int wr, int wc, int fr, int fq) const {
        const int row0 = u.pm * BM + wr * 64 + fr, col0 = u.pn * BM + wc * 32 + 4 * fq;
#pragma unroll
        for (int ai = 0; ai < 2; ++ai)
#pragma unroll
            for (int m = 0; m < 4; ++m) { float* rowp = C + (size_t)(row0 + ai * HALF + m * 16) * ldc + col0;
#pragma unroll
                for (int bj = 0; bj < 2; ++bj)
#pragma unroll
                    for (int n = 0; n < 2; ++n) *(f32x4*)(rowp + bj * HALF + n * 16) = acc[ai][bj][m][n]; }
    }
};
struct EpiIn {
    static constexpr bool PERM = true;
    bf16_t *Q, *K, *V, *SR, *UH, *SZG, *SZS, *LA; const float* b_gate;
    template <int KIND>
    __device__ __forceinline__ void run(const f32x4 (&acc)[2][2][4][2], bf16_t* base, int ld, int row0, int col0) const {
#pragma unroll
        for (int bj = 0; bj < 2; ++bj) {
            const int c = col0 + bj * HALF;
            f32x4 b0 = (f32x4){0.f, 0.f, 0.f, 0.f}, b1 = b0;
            if (KIND == 5) { b0 = *(const f32x4*)(b_gate + c); b1 = *(const f32x4*)(b_gate + c + 4); }
#pragma unroll
            for (int ai = 0; ai < 2; ++ai)
#pragma unroll
                for (int m = 0; m < 4; ++m) {
                    const int row = row0 + ai * HALF + m * 16;
                    f32x4 v0 = acc[ai][bj][m][0], v1 = acc[ai][bj][m][1];
                    if (KIND == 0) { v0 = v0 * 0.08838834764831845f; v1 = v1 * 0.08838834764831845f; }
                    if (KIND == 2) {
#pragma unroll
                        for (int j = 0; j < 4; ++j) { v0[j] = v0[j] * sigmoidf_(v0[j]); v1[j] = v1[j] * sigmoidf_(v1[j]); } }
                    if (KIND == 4) {
#pragma unroll
                        for (int j = 0; j < 4; ++j) { v0[j] = sigmoidf_(v0[j]); v1[j] = sigmoidf_(v1[j]); } }
                    if (KIND == 5) {
#pragma unroll
                        for (int j = 0; j < 4; ++j) { v0[j] = logsigf_(v0[j] + b0[j]) * 0.0625f; v1[j] = logsigf_(v1[j] + b1[j]) * 0.0625f; } }
                    bf16_t* p = (KIND == 3) ? base + ((size_t)((c >> 4) * 2048 + (row >> 4)) * 384 + (row & 15) * 16 + (c & 15))
                                            : base + ((size_t)row * ld + c);
                    *(u32x4*)p = pack8(v0, v1);
                }
        }
    }
    __device__ __forceinline__ void operator()(const f32x4 (&acc)[2][2][4][2], const Unit& u, int wr, int wc, int fr, int fq) const {
        const int pn = u.pn; const int row0 = u.pm * BM + wr * 64 + fr, cw = wc * 32 + 8 * fq;
        if (pn < 2)       run<0>(acc, Q, 512, row0, pn * 256 + cw);
        else if (pn < 4)  run<1>(acc, K, 512, row0, (pn - 2) * 256 + cw);
        else if (pn < 8)  run<1>(acc, V, 1024, row0, (pn - 4) * 256 + cw);
        else if (pn < 12) run<2>(acc, SR, 1024, row0, (pn - 8) * 256 + cw);
        else if (pn < 16) run<3>(acc, UH, 0, row0, (pn - 12) * 256 + cw);
        else if (pn < 20) run<4>(acc, SZG, 1024, row0, (pn - 16) * 256 + cw);
        else if (pn < 24) run<4>(acc, SZS, 1024, row0, (pn - 20) * 256 + cw);
        else              run<5>(acc, LA, 512, row0, (pn - 24) * 256 + cw);
    }
};
struct EpiE {
    static constexpr bool PERM = true;
    bf16_t* UH;
    __device__ __forceinline__ void operator()(const f32x4 (&acc)[2][2][4][2], const Unit& u, int wr, int wc, int fr, int fq) const {
        const int row0 = u.pm * BM + wr * 64 + fr, col0 = 256 + wc * 32 + 8 * fq;
#pragma unroll
        for (int ai = 0; ai < 2; ++ai)
#pragma unroll
            for (int m = 0; m < 4; ++m) *(u32x4*)(UH + (size_t)(row0 + ai * HALF + m * 16) * 384 + col0) = pack8(acc[ai][0][m][0], acc[ai][0][m][1]);
    }
};
struct EpiS {
    static constexpr bool PERM = true;
    bf16_t* GS;
    __device__ __forceinline__ void operator()(const f32x4 (&acc)[2][2][4][2], const Unit& u, int wr, int wc, int fr, int fq) const {
        const int g = u.pn; const int rg0 = (u.pm & 7) * BM + wr * 64 + fr;
        bf16_t* base = GS + ((size_t)(rg0 * 16 + wc * 2 + (fq >> 1)) * 1024 + g * 16 + (fq & 1) * 8);
#pragma unroll
        for (int ai = 0; ai < 2; ++ai)
#pragma unroll
            for (int m = 0; m < 4; ++m) {
#pragma unroll
                for (int bj = 0; bj < 2; ++bj) {
                    f32x4 v0 = acc[ai][bj][m][0], v1 = acc[ai][bj][m][1];
#pragma unroll
                    for (int j = 0; j < 4; ++j) { v0[j] = gelu_tanh(v0[j]); v1[j] = gelu_tanh(v1[j]); }
                    *(u32x4*)(base + (size_t)(ai * HALF + m * 16) * 16384 + bj * 8192) = pack8(v0, v1); }
                asm volatile("" ::: "memory"); }
    }
};
struct EpiYG {
    static constexpr bool PERM = true;
    const bf16_t* SZG; bf16_t* YG;
    __device__ __forceinline__ void operator()(const f32x4 (&acc)[2][2][4][2], const Unit& u, int wr, int wc, int fr, int fq) const {
        const int row0 = u.pm * BM + wr * 64 + fr, col0 = u.pn * BM + wc * 32 + 8 * fq;
#pragma unroll
        for (int ai = 0; ai < 2; ++ai)
#pragma unroll
            for (int m = 0; m < 4; ++m)
#pragma unroll
                for (int bj = 0; bj < 2; ++bj) { const size_t off = (size_t)(row0 + ai * HALF + m * 16) * 1024 + col0 + bj * HALF;
                    const u32x4 z = *(const u32x4*)(SZG + off); f32x4 v0 = acc[ai][bj][m][0], v1 = acc[ai][bj][m][1];
                    v0[0] *= bflo(z.x); v0[1] *= bfhi(z.x); v0[2] *= bflo(z.y); v0[3] *= bfhi(z.y); v1[0] *= bflo(z.z); v1[1] *= bfhi(z.z); v1[2] *= bflo(z.w); v1[3] *= bfhi(z.w);
                    *(u32x4*)(YG + off) = pack8(v0, v1); }
    }
};
struct EpiGlu {
    static constexpr bool PERM = true;
    const bf16_t *YG, *SZS; bf16_t* MIX; const float* b_glu;
    __device__ __forceinline__ void operator()(const f32x4 (&acc)[2][2][4][2], const Unit& u, int wr, int wc, int fr, int fq) const {
        const int row0 = u.pm * BM + wr * 64 + fr, c = u.pn * HALF + wc * 32 + 8 * fq;
        const f32x4 bv0 = *(const f32x4*)(b_glu + c), bv1 = *(const f32x4*)(b_glu + c + 4), bg0 = *(const f32x4*)(b_glu + 1024 + c), bg1 = *(const f32x4*)(b_glu + 1024 + c + 4);
#pragma unroll
        for (int ai = 0; ai < 2; ++ai)
#pragma unroll
            for (int m = 0; m < 4; ++m) { const size_t off = (size_t)(row0 + ai * HALF + m * 16) * 1024 + c;
                const u32x4 y = *(const u32x4*)(YG + off), z = *(const u32x4*)(SZS + off);
                f32x4 v0 = acc[ai][0][m][0] + bv0, v1 = acc[ai][0][m][1] + bv1, g0 = acc[ai][1][m][0] + bg0, g1 = acc[ai][1][m][1] + bg1;
#pragma unroll
                for (int j = 0; j < 4; ++j) { v0[j] *= sigmoidf_(g0[j]); v1[j] *= sigmoidf_(g1[j]); }
                v0[0] = bflo(y.x) + bflo(z.x) * v0[0]; v0[1] = bfhi(y.x) + bfhi(z.x) * v0[1]; v0[2] = bflo(y.y) + bflo(z.y) * v0[2]; v0[3] = bfhi(y.y) + bfhi(z.y) * v0[3];
                v1[0] = bflo(y.z) + bflo(z.z) * v1[0]; v1[1] = bfhi(y.z) + bfhi(z.z) * v1[1]; v1[2] = bflo(y.w) + bflo(z.w) * v1[2]; v1[3] = bfhi(y.w) + bfhi(z.w) * v1[3];
                *(u32x4*)(MIX + off) = pack8(v0, v1); }
    }
};
struct EpiRelu2 {
    static constexpr bool PERM = true;
    bf16_t* O; int ldc;
    __device__ __forceinline__ void operator()(const f32x4 (&acc)[2][2][4][2], const Unit& u, int wr, int wc, int fr, int fq) const {
        const int row0 = u.pm * BM + wr * 64 + fr, col0 = u.pn * BM + wc * 32 + 8 * fq;
#pragma unroll
        for (int ai = 0; ai < 2; ++ai)
#pragma unroll
            for (int m = 0; m < 4; ++m)
#pragma unroll
                for (int bj = 0; bj < 2; ++bj) { f32x4 v0 = acc[ai][bj][m][0], v1 = acc[ai][bj][m][1];
#pragma unroll
                    for (int j = 0; j < 4; ++j) { const float a = fmaxf(v0[j], 0.f), b = fmaxf(v1[j], 0.f); v0[j] = a * a; v1[j] = b * b; }
                    *(u32x4*)(O + (size_t)(row0 + ai * HALF + m * 16) * ldc + col0 + bj * HALF) = pack8(v0, v1); }
    }
};

template <class Epi, class Sched, bool ALIGN_EPI>
__device__ __forceinline__ void gemm_phase(PG8_LAS unsigned char* lds, const Gemm g, const Sched& S, const Epi& E, const int wid  ) {
    int lane_ = (int)__builtin_amdgcn_mbcnt_hi(~0u, __builtin_amdgcn_mbcnt_lo(~0u, 0u)); asm volatile("" : "+v"(lane_));
    const int lane = lane_, tid = wid * 64 + lane, wr = wid >> 2, wc = wid & 3, fr = lane & 15, fq = lane >> 4;
    const int nt = g.K / BK;
    unsigned voffA[2], voffB[2];
#pragma unroll
    for (int i = 0; i < 2; ++i) { int R, C; stage_rc(tid * 16 + i * 8192, R, C); const int Rb = Epi::PERM ? ((R & ~31) + perm32(R & 31)) : R;
        voffA[i] = (unsigned)(R * g.lda + C) * 2u; voffB[i] = (unsigned)(Rb * g.ldb + C) * 2u; }
    const size_t kstep = (size_t)(BK * 2);
    const size_t hstepA = (size_t)HALF * g.lda * 2, hstepB = (size_t)HALF * g.ldb * 2;
    const size_t tstepA = 2 * hstepA, tstepB = (size_t)g.tstepB_rows * g.ldb * 2;
    const unsigned ldsw = (unsigned)wid * 1024u;
    const int aoff = lds_byte(wr * 64 + fr, fq * 8), boff = lds_byte(wc * 32 + fr, fq * 8);
#define PG8_SA(b, h) (((b) * 2 + (h)) * HTB)
#define PG8_SB(b, h) ((4 + (b) * 2 + (h)) * HTB)
#define PG8_STAGE(bufoff, gbase, voff) do { _Pragma("unroll") for (int _i = 0; _i < 2; ++_i) \
        __builtin_amdgcn_global_load_lds((const unsigned*)((const char*)(gbase) + (voff)[_i]), (PG8_LAS unsigned*)(lds + (bufoff) + ldsw + _i * 8192), 16, 0, 0); } while (0)
#define PG8_LDA(dst, b, h) do { _Pragma("unroll") for (int m = 0; m < 4; ++m) _Pragma("unroll") for (int k = 0; k < 2; ++k) dst[m][k] = *(const PG8_LAS bf16x8*)(lds + PG8_SA(b, h) + aoff + m * 2048 + k * 1024); } while (0)
#define PG8_LDB(dst, b, h) do { _Pragma("unroll") for (int n = 0; n < 2; ++n) _Pragma("unroll") for (int k = 0; k < 2; ++k) dst[n][k] = *(const PG8_LAS bf16x8*)(lds + PG8_SB(b, h) + boff + n * 2048 + k * 1024); } while (0)
#define PG8_MMA(ai, bj, At, Bt) do { __builtin_amdgcn_s_setprio(1); _Pragma("unroll") for (int m = 0; m < 4; ++m) _Pragma("unroll") for (int n = 0; n < 2; ++n) _Pragma("unroll") for (int k = 0; k < 2; ++k) \
        acc[ai][bj][m][n] = __builtin_amdgcn_mfma_f32_16x16x32_bf16(Bt[n][k], At[m][k], acc[ai][bj][m][n], 0, 0, 0); __builtin_amdgcn_s_setprio(0); } while (0)
#define PG8_WAIT_V(n) asm volatile("s_waitcnt vmcnt(" #n ")" ::: "memory")
#define PG8_WAIT_L(n) asm volatile("s_waitcnt lgkmcnt(" #n ")" ::: "memory")
#define PG8_BAR __builtin_amdgcn_s_barrier()
#define PG8_SCHED __builtin_amdgcn_sched_barrier(0)
    Unit cur, nxt; int ui = 0;
    if (!S.next(0, cur)) return;
    f32x4 acc[2][2][4][2];
#pragma unroll
    for (int a = 0; a < 2; ++a)
#pragma unroll
        for (int b = 0; b < 2; ++b)
#pragma unroll
            for (int m = 0; m < 4; ++m)
#pragma unroll
                for (int n = 0; n < 2; ++n) acc[a][b][m][n] = (f32x4){0.f, 0.f, 0.f, 0.f};
    bf16x8 At[4][2], B0[2][2], B1[2][2];
    const char* cA = (const char*)g.A + (size_t)cur.pm * tstepA; const char* cB = (const char*)g.Bt + (size_t)cur.pn * tstepB;
    PG8_STAGE(PG8_SB(0, 0), cB, voffB); PG8_STAGE(PG8_SB(0, 1), cB + hstepB, voffB); PG8_STAGE(PG8_SA(0, 0), cA, voffA); PG8_STAGE(PG8_SA(0, 1), cA + hstepA, voffA);
    if (wr == 1) PG8_BAR;
    PG8_WAIT_V(2); PG8_BAR;
    PG8_STAGE(PG8_SB(1, 0), cB + kstep, voffB); PG8_STAGE(PG8_SA(1, 0), cA + kstep, voffA); PG8_STAGE(PG8_SB(1, 1), cB + hstepB + kstep, voffB);
    PG8_WAIT_V(6); PG8_BAR;
    for (;;) {
        const bool has_next = S.next(ui + 1, nxt);
        const char* nA = has_next ? (const char*)g.A + (size_t)nxt.pm * tstepA : cA; const char* nB = has_next ? (const char*)g.Bt + (size_t)nxt.pn * tstepB : cB;
        for (int t = 0; t < nt; t += 2) {
            const bool last = (t == nt - 2);
            const char* a1 = cA + (size_t)(t + 1) * kstep;
            const char* a2 = last ? nA : cA + (size_t)(t + 2) * kstep; const char* b2 = last ? nB : cB + (size_t)(t + 2) * kstep;
            const char* a3 = a2 + kstep; const char* b3 = b2 + kstep;
            PG8_LDB(B0, 0, 0); PG8_LDB(B1, 0, 1); PG8_SCHED; PG8_LDA(At, 0, 0); PG8_STAGE(PG8_SA(1, 1), a1 + hstepA, voffA);
            PG8_WAIT_V(8); PG8_WAIT_L(0); PG8_BAR; PG8_MMA(0, 0, At, B0); PG8_MMA(0, 1, At, B1); PG8_BAR; PG8_SCHED;
            PG8_LDA(At, 0, 1); PG8_STAGE(PG8_SB(0, 0), b2, voffB); PG8_STAGE(PG8_SB(0, 1), b2 + hstepB, voffB); PG8_STAGE(PG8_SA(0, 0), a2, voffA);
            PG8_WAIT_V(8); PG8_WAIT_L(0); PG8_BAR; PG8_MMA(1, 0, At, B0); PG8_MMA(1, 1, At, B1); PG8_BAR; PG8_SCHED;
            PG8_LDB(B0, 1, 0); PG8_LDB(B1, 1, 1); PG8_SCHED; PG8_LDA(At, 1, 0); PG8_STAGE(PG8_SA(0, 1), a2 + hstepA, voffA);
            PG8_WAIT_V(8); PG8_WAIT_L(0); PG8_BAR; PG8_MMA(0, 0, At, B0); PG8_MMA(0, 1, At, B1); PG8_BAR; PG8_SCHED;
            PG8_LDA(At, 1, 1); PG8_STAGE(PG8_SB(1, 0), b3, voffB); PG8_STAGE(PG8_SB(1, 1), b3 + hstepB, voffB); PG8_STAGE(PG8_SA(1, 0), a3, voffA);
            PG8_WAIT_V(8); PG8_WAIT_L(0); PG8_BAR; PG8_MMA(1, 0, At, B0); PG8_MMA(1, 1, At, B1); PG8_BAR; PG8_SCHED;
        }
        if constexpr (ALIGN_EPI) { if (wr == 0) PG8_BAR; }
        { int le = (int)__builtin_amdgcn_mbcnt_hi(~0u, __builtin_amdgcn_mbcnt_lo(~0u, 0u)); asm volatile("" : "+v"(le)); E(acc, cur, wr, wc, le & 15, le >> 4); }
        if (!has_next) break;
#pragma unroll
        for (int a = 0; a < 2; ++a)
#pragma unroll
            for (int b = 0; b < 2; ++b)
#pragma unroll
                for (int m = 0; m < 4; ++m)
#pragma unroll
                    for (int n = 0; n < 2; ++n) acc[a][b][m][n] = (f32x4){0.f, 0.f, 0.f, 0.f};
        cur = nxt; cA = nA; cB = nB; ++ui;
        if constexpr (ALIGN_EPI) { if (wr == 1) PG8_BAR; }
    }
    PG8_WAIT_V(0);
    if constexpr (!ALIGN_EPI) { if (wr == 0) PG8_BAR; }
    PG8_BAR;
#undef PG8_SA
#undef PG8_SB
#undef PG8_STAGE
#undef PG8_LDA
#undef PG8_LDB
#undef PG8_MMA
#undef PG8_WAIT_V
#undef PG8_WAIT_L
#undef PG8_BAR
#undef PG8_SCHED
}
}

constexpr int NWAVES = 8;
constexpr int BATCH = 8, SEQ = 4096, D = 1024, M = BATCH * SEQ, NMETA = 16;
constexpr int NH = 4, DKH = 128, DVH = 256, GKEY = 512, GVAL = 1024, RANK = 16;
constexpr int SG = 64, SHG = 16, SN = 64, FF = 4096, IN_W = 6160, NIN = 6656;
constexpr int SRC_A = 3072, SRC_U = 3088;
constexpr float EPS = 1e-6f;
constexpr int N_LAUNCHES = MK_N_LAUNCHES;
constexpr int N_PHASES = 11;

constexpr size_t MiB = 1u << 20;
constexpr size_t WS_CTL = 0, CTL_ZERO_BYTES = 1 * MiB;
constexpr size_t WS_SMALL = 1 * MiB;
constexpr size_t WS_WIN = 2 * MiB, WS_WO = 15 * MiB, WS_WGLU = 17 * MiB, WS_WOUT = 21 * MiB, WS_WFF1 = 23 * MiB, WS_WFF2 = 31 * MiB;
constexpr size_t WS_TZ = 39 * MiB;
constexpr size_t WS_MS = 51 * MiB;
constexpr size_t WS_XN = 56 * MiB;
constexpr size_t WS_Q = 120 * MiB, WS_K = 152 * MiB, WS_V = 184 * MiB, WS_SR = 248 * MiB, WS_LA = 312 * MiB, WS_UH = 344 * MiB;
constexpr size_t WS_GS = 120 * MiB;
constexpr size_t WS_YG = 184 * MiB;
constexpr size_t WS_MIX = 248 * MiB;
constexpr size_t WS_T = 312 * MiB;
constexpr size_t WS_F1 = 120 * MiB;
constexpr size_t WS_T2 = 376 * MiB;
constexpr size_t WS_DS = 440 * MiB;
constexpr size_t WS_END = 504 * MiB;
constexpr size_t SM_KM = 0;
constexpr size_t SM_VM = SM_KM + 16 * 512 * 4;
constexpr size_t SM_AL = SM_VM + 16 * 1024 * 4;
constexpr size_t SM_UM = SM_AL + 16 * 16 * 4;
constexpr size_t SM_L16 = SM_UM + 16 * 1024 * 4;
constexpr size_t SM_END = SM_L16 + 64 * 64 * 2 * 4;
static_assert(SM_END <= MiB, "small region");
constexpr int CW_BAR = 4096;

constexpr int RING_BYTES = 139264;
constexpr int LDSCTL_OFF = RING_BYTES, MISC_OFF = LDSCTL_OFF + 320;
constexpr int LDS_BYTES = 147456;

#define GAS __attribute__((address_space(1)))
#define LAS __attribute__((address_space(3)))
typedef unsigned short bf16;
typedef unsigned v4u __attribute__((ext_vector_type(4)));
typedef unsigned v2u __attribute__((ext_vector_type(2)));
typedef float f32x4 __attribute__((ext_vector_type(4)));
typedef float f32x16 __attribute__((ext_vector_type(16)));
typedef short bf16x8 __attribute__((ext_vector_type(8)));
#define LDS_WAIT() asm volatile("s_waitcnt lgkmcnt(0)" ::: "memory")
#define VM_WAIT() asm volatile("s_waitcnt vmcnt(0)" ::: "memory")
__device__ __forceinline__ unsigned f2bf(float f) { unsigned u = __builtin_bit_cast(unsigned, f); return (u + 0x7fffu + ((u >> 16) & 1u)) >> 16; }
__device__ __forceinline__ unsigned pk2(float lo, float hi) { return f2bf(lo) | (f2bf(hi) << 16); }
__device__ __forceinline__ float bf2f(bf16 b) { return __uint_as_float((unsigned)b << 16); }

#define XB_TMO      128
#define XB_XCNT(j)  (256  + 64 * (j))
#define XB_XSUB(j)  (1280 + 64 * (j))
#define XB_XGEN(j)  (2304 + 64 * (j))
#define XB_TOP      3328
#define XB_TOPGEN   3392
#define XCD_BAR_WORDS 3456
#define XB_SPIN_CAP (1u << 18)
__device__ __forceinline__ unsigned xb_ld(unsigned* p)              { return __hip_atomic_load(p, __ATOMIC_RELAXED, __HIP_MEMORY_SCOPE_AGENT); }
__device__ __forceinline__ unsigned xb_add(unsigned* p, unsigned v) { return __hip_atomic_fetch_add(p, v, __ATOMIC_RELAXED, __HIP_MEMORY_SCOPE_AGENT); }
__device__ __forceinline__ unsigned xb_xcc_id() { return (unsigned)__builtin_amdgcn_s_getreg((3 << 11) | 20) & 0xFu; }
#define XB_SPIN(cond, bar) do { unsigned _sp = 0; while (cond) { __builtin_amdgcn_s_sleep(1); \
    if ((++_sp & 255u) == 0u) { if (xb_ld(&(bar)[XB_TMO])) break; if (_sp > XB_SPIN_CAP) { atomicAdd(&(bar)[XB_TMO], 1u); break; } } } } while (0)
struct XcdBarrier { unsigned* bar; unsigned x; volatile LAS unsigned* st; };
__device__ __forceinline__ XcdBarrier xcd_barrier_post(unsigned* bar, volatile LAS unsigned* st, bool t0) {
    XcdBarrier b; b.bar = bar; b.x = xb_xcc_id(); b.st = st;
    if (t0) (void)xb_add(&bar[XB_XCNT(b.x)], 1u);
    return b;
}
__device__ __forceinline__ void xcd_barrier_complete(unsigned* bar, unsigned x, unsigned& nloc, unsigned& nx) {
    const unsigned G = gridDim.x * gridDim.y * gridDim.z;
    unsigned sum, cnt, mine, sp = 0u;
    for (;;) {
        sum = 0u; cnt = 0u; mine = 0u;
#pragma unroll
        for (unsigned j = 0; j < 16; ++j) { const unsigned c = xb_ld(&bar[XB_XCNT(j)]); sum += c; cnt += (c > 0u) ? 1u : 0u; mine = (j == x) ? c : mine; }
        if (sum == G) break;
        __builtin_amdgcn_s_sleep(1);
        if ((++sp & 255u) == 0u) { if (xb_ld(&bar[XB_TMO])) break; if (sp > XB_SPIN_CAP) { atomicAdd(&bar[XB_TMO], 1u); break; } }
    }
    nloc = mine > 0u ? mine : 1u; nx = cnt > 0u ? cnt : 1u;
}
__device__ __forceinline__ void xcd_barrier(const XcdBarrier& b, bool t0) {
    asm volatile("s_waitcnt vmcnt(0)" ::: "memory");
    __syncthreads();
    if (t0) {
        unsigned* bar = b.bar;
        __builtin_amdgcn_s_waitcnt(0);
        unsigned nloc = b.st[0], nx = b.st[1];
        if (nloc == 0u) { xcd_barrier_complete(bar, b.x, nloc, nx); b.st[0] = nloc; b.st[1] = nx; }
        const unsigned old = xb_add(&bar[XB_XSUB(b.x)], 1u);
        const unsigned gen = old / nloc;
        if (old + 1u == (gen + 1u) * nloc) {
            __builtin_amdgcn_fence(__ATOMIC_RELEASE, "agent");
            asm volatile("s_waitcnt vmcnt(0)" ::: "memory");
            const unsigned og = xb_add(&bar[XB_TOP], 1u);
            const unsigned tg = og / nx;
            if (og + 1u == (tg + 1u) * nx) xb_add(&bar[XB_TOPGEN], 1u);
            else XB_SPIN(xb_ld(&bar[XB_TOPGEN]) == tg, bar);
            __builtin_amdgcn_fence(__ATOMIC_ACQUIRE, "agent");
            xb_add(&bar[XB_XGEN(b.x)], 1u);
            asm volatile("s_waitcnt vmcnt(0)" ::: "memory");
        } else {
            XB_SPIN(xb_ld(&bar[XB_XGEN(b.x)]) == gen, bar);
            __builtin_amdgcn_fence(__ATOMIC_ACQUIRE, "agent");
            asm volatile("s_waitcnt vmcnt(0)" ::: "memory");
        }
    }
    __syncthreads();
}

struct Args { const float* in[24]; float* out; unsigned char* ws; int ph_lo, ph_hi, li, pad; };

__device__ __forceinline__ int launder_idx(int i) { asm volatile("" : "+s"(i)); return i; }
__device__ __forceinline__ float wave_sum(float v) {
#pragma unroll
    for (int o = 1; o < 64; o <<= 1) v += __shfl_xor(v, o);
    return v;
}

__device__ __forceinline__ void p0_transpose_item(const float* W, int ldw, int src_col0, int K, bf16* WT, int dst_row0, LAS float* scr, int kb, int lane) {
    const int k0 = 64 * kb;
#pragma unroll 8
    for (int i = 0; i < 32; ++i) { const int kk = 2 * i + (lane >> 5); scr[kk * 33 + (lane & 31)] = W[(size_t)(k0 + kk) * ldw + src_col0 + (lane & 31)]; }
    LDS_WAIT(); asm volatile("" ::: "memory");
    const int c = lane & 7;
#pragma unroll
    for (int j = 0; j < 4; ++j) { const int n = (lane >> 3) + 8 * j; const LAS float* s = scr + (8 * c) * 33 + n;
        v4u o; o.x = pk2(s[0 * 33], s[1 * 33]); o.y = pk2(s[2 * 33], s[3 * 33]); o.z = pk2(s[4 * 33], s[5 * 33]); o.w = pk2(s[6 * 33], s[7 * 33]);
        *(GAS v4u*)(WT + (size_t)(dst_row0 + n) * K + k0 + 8 * c) = o; }
    LDS_WAIT(); asm volatile("" ::: "memory");
}
__device__ __forceinline__ void rms_row_to_bf16(const float* xrow, const float* gain, bf16* orow, int lane) {
    const GAS f32x4* xr = (const GAS f32x4*)xrow + lane; const GAS f32x4* gr = (const GAS f32x4*)gain + lane;
    f32x4 v[4]; float s = 0.f;
#pragma unroll
    for (int j = 0; j < 4; ++j) { v[j] = xr[64 * j]; s += (v[j].x * v[j].x + v[j].y * v[j].y) + (v[j].z * v[j].z + v[j].w * v[j].w); }
    const float rs = 1.0f / sqrtf(wave_sum(s) * (1.f / 1024.f) + EPS);
    GAS unsigned long long* o8 = (GAS unsigned long long*)orow + lane;
#pragma unroll
    for (int j = 0; j < 4; ++j) { const f32x4 g = gr[64 * j];
        o8[64 * j] = (unsigned long long)pk2(v[j].x * rs * g.x, v[j].y * rs * g.y) | ((unsigned long long)pk2(v[j].z * rs * g.z, v[j].w * rs * g.w) << 32); }
}
struct cpx { float r, i; };
__device__ __forceinline__ cpx cmul(cpx a, cpx b) { return cpx{a.r * b.r - a.i * b.i, a.r * b.i + a.i * b.r}; }

namespace gla {
typedef short s16x4 __attribute__((ext_vector_type(4)));
typedef short v4i16_t __attribute__((ext_vector_type(4)));
constexpr int QP = 136, XP = 160, VP = 288, PP = 72, OP = 264;
constexpr int O_QE = 0, O_B = 17408, O_KI = O_B + 33792, O_KX = O_KI + 17408, O_V = O_KX + 64 * XP * 2, O_P = O_V + 64 * VP * 2, O_DK = O_P + 64 * PP * 2, O_TOT = O_DK + 512, O_END = O_TOT + 2048;
static_assert(O_END <= RING_BYTES, "gla lds");
__device__ __forceinline__ s16x4 tr4(const LAS unsigned char* p) { return __builtin_bit_cast(s16x4, __builtin_amdgcn_ds_read_tr16_b64_v4i16((LAS v4i16_t*)p)); }
__device__ __forceinline__ bf16x8 cat8(s16x4 a, s16x4 b) { return __builtin_shufflevector(a, b, 0, 1, 2, 3, 4, 5, 6, 7); }

struct Pref { unsigned la[8]; v4u k[2], q[2], v[4]; };
template <bool WANT_O>
__device__ __forceinline__ void prefetch(Pref& pf, const bf16* __restrict__ Qg, const bf16* __restrict__ Kg, const bf16* __restrict__ LAg, const bf16* __restrict__ Vg, int m0, int h, int tid) {
    const int kc = tid & 127, tq = tid >> 7;
    const bf16* lp = LAg + (size_t)(m0 + 16 * tq) * GKEY + h * DKH + kc;
#pragma unroll
    for (int i = 0; i < 8; ++i) pf.la[i] = (unsigned)lp[(size_t)(2 * i) * GKEY] | ((unsigned)lp[(size_t)(2 * i + 1) * GKEY] << 16);
#pragma unroll
    for (int i = 0; i < 2; ++i) { const size_t o = (size_t)(m0 + (tid >> 4) + 32 * i) * GKEY + h * DKH + (tid & 15) * 8;
        pf.k[i] = *(const GAS v4u*)(Kg + o); if (WANT_O) pf.q[i] = *(const GAS v4u*)(Qg + o); }
#pragma unroll
    for (int j = 0; j < 4; ++j) pf.v[j] = *(const GAS v4u*)(Vg + (size_t)(m0 + (tid >> 5) + 16 * j) * GVAL + h * DVH + (tid & 31) * 8);
}

template <bool WANT_O>
__device__ __forceinline__ void chunk(LAS unsigned char* lds, const bf16* __restrict__ Qg, const bf16* __restrict__ Kg, const bf16* __restrict__ LAg, const bf16* __restrict__ Vg,
                                      const bf16* __restrict__ SRg, const float* __restrict__ gn, bf16* __restrict__ OG, int m0, int m0n, int h, f32x16 (&S)[4], Pref& pf, float& dsum,
                                      int tid, int wid, int lane) {
    LAS bf16* QE = (LAS bf16*)(lds + O_QE); LAS float* Bm = (LAS float*)(lds + O_B); LAS bf16* OT = (LAS bf16*)(lds + O_B); LAS bf16* KI = (LAS bf16*)(lds + O_KI);
    LAS bf16* KX = (LAS bf16*)(lds + O_KX); LAS bf16* Vs = (LAS bf16*)(lds + O_V); LAS bf16* P = (LAS bf16*)(lds + O_P);
    LAS float* DKs = (LAS float*)(lds + O_DK); LAS float* TOT = (LAS float*)(lds + O_TOT);
    const int kc = tid & 127, tq = tid >> 7;
    float c16[16];
    { float run = 0.f;
#pragma unroll
      for (int i = 0; i < 8; ++i) { run += pg8::bflo(pf.la[i]); c16[2 * i] = run; run += pg8::bfhi(pf.la[i]); c16[2 * i + 1] = run; }
      TOT[tq * 128 + kc] = run; }
    LDS_WAIT(); __builtin_amdgcn_s_barrier(); asm volatile("" ::: "memory");
    { const float t0 = TOT[kc], t1 = TOT[128 + kc], t2 = TOT[256 + kc], t3 = TOT[384 + kc];
      const float off = tq == 0 ? 0.f : (tq == 1 ? t0 : (tq == 2 ? t0 + t1 : t0 + t1 + t2));
      if (tq == 0) dsum += (t0 + t1) + (t2 + t3);
#pragma unroll
      for (int i = 0; i < 16; ++i) Bm[(16 * tq + i) * 128 + kc] = off + c16[i]; }
#pragma unroll
    for (int j = 0; j < 4; ++j) *(LAS v4u*)(Vs + ((tid >> 5) + 16 * j) * VP + (tid & 31) * 8) = pf.v[j];
    LDS_WAIT(); __builtin_amdgcn_s_barrier(); asm volatile("" ::: "memory");
    { const int kblk = (tid & 15) * 8, b16 = kblk & ~15, p0 = b16 + ((kblk & 8) ? 4 : 0), p1 = b16 + ((kblk & 8) ? 12 : 8);
#pragma unroll
      for (int i = 0; i < 2; ++i) { const int t = (tid >> 4) + 32 * i;
        const f32x4 b0 = *(const LAS f32x4*)(Bm + t * 128 + kblk), b1 = *(const LAS f32x4*)(Bm + t * 128 + kblk + 4);
        float e[8], r[8];
#pragma unroll
        for (int j = 0; j < 4; ++j) { e[j] = __expf(b0[j]); e[4 + j] = __expf(b1[j]); }
#pragma unroll
        for (int j = 0; j < 8; ++j) r[j] = __builtin_amdgcn_rcpf(e[j]);
        const v4u kw = pf.k[i];
        const float k0 = pg8::bflo(kw.x) * r[0], k1 = pg8::bfhi(kw.x) * r[1], k2 = pg8::bflo(kw.y) * r[2], k3 = pg8::bfhi(kw.y) * r[3];
        const float k4 = pg8::bflo(kw.z) * r[4], k5 = pg8::bfhi(kw.z) * r[5], k6 = pg8::bflo(kw.w) * r[6], k7 = pg8::bfhi(kw.w) * r[7];
        const unsigned w0 = pk2(k0, k1), w1 = pk2(k2, k3), w2 = pk2(k4, k5), w3 = pk2(k6, k7);
        *(LAS v4u*)(KX + t * XP + kblk) = (v4u){w0, w1, w2, w3};
        if (WANT_O) {
            *(LAS v2u*)(KI + t * QP + p0) = (v2u){w0, w1}; *(LAS v2u*)(KI + t * QP + p1) = (v2u){w2, w3};
            const v4u qw = pf.q[i];
            const unsigned q0 = pk2(pg8::bflo(qw.x) * e[0], pg8::bfhi(qw.x) * e[1]), q1 = pk2(pg8::bflo(qw.y) * e[2], pg8::bfhi(qw.y) * e[3]);
            const unsigned q2 = pk2(pg8::bflo(qw.z) * e[4], pg8::bfhi(qw.z) * e[5]), q3 = pk2(pg8::bflo(qw.w) * e[6], pg8::bfhi(qw.w) * e[7]);
            *(LAS v2u*)(QE + t * QP + p0) = (v2u){q0, q1}; *(LAS v2u*)(QE + t * QP + p1) = (v2u){q2, q3};
        } }
      if (tid < 16) { const f32x4 l0 = *(const LAS f32x4*)(Bm + 63 * 128 + 8 * tid), l1 = *(const LAS f32x4*)(Bm + 63 * 128 + 8 * tid + 4);
        *(LAS f32x4*)(DKs + 8 * tid) = (f32x4){__expf(l0[0]), __expf(l0[1]), __expf(l0[2]), __expf(l0[3])};
        *(LAS f32x4*)(DKs + 8 * tid + 4) = (f32x4){__expf(l1[0]), __expf(l1[1]), __expf(l1[2]), __expf(l1[3])}; } }
    if (m0n >= 0) prefetch<WANT_O>(pf, Qg, Kg, LAg, Vg, m0n, h, tid);
    LDS_WAIT(); __builtin_amdgcn_s_barrier(); asm volatile("" ::: "memory");
    const int fr = lane & 15, fq = lane >> 4, r = lane & 31, hh = lane >> 5, v0 = 32 * wid;
    const int trq = (lane & 15) >> 2, trp = lane & 3, blk = (lane >> 4) & 1;
    if (WANT_O) {
#pragma unroll
        for (int rep = 0; rep < 2; ++rep) {
            const int idx = wid + 8 * rep;
            if (idx < 10) {
                const int ti = idx >= 6 ? 3 : (idx >= 3 ? 2 : (idx >= 1 ? 1 : 0)), si = idx - (ti * (ti + 1)) / 2;
                pg8::f32x4 acc = (pg8::f32x4){0.f, 0.f, 0.f, 0.f};
#pragma unroll
                for (int ks = 0; ks < 4; ++ks) {
                    const bf16x8 a = *(const LAS bf16x8*)(QE + (16 * ti + fr) * QP + 32 * ks + 8 * fq);
                    const bf16x8 b = *(const LAS bf16x8*)(KI + (16 * si + fr) * QP + 32 * ks + 8 * fq);
                    acc = __builtin_amdgcn_mfma_f32_16x16x32_bf16(a, b, acc, 0, 0, 0);
                }
                const int s = 16 * si + fr;
#pragma unroll
                for (int rg = 0; rg < 4; ++rg) { const int t = 16 * ti + 4 * fq + rg; P[t * PP + s] = (bf16)f2bf(s <= t ? acc[rg] : 0.f); }
            }
        }
        LDS_WAIT(); __builtin_amdgcn_s_barrier(); asm volatile("" ::: "memory");
    }
    bf16x8 vf[4];
    { const LAS unsigned char* vb = (const LAS unsigned char*)Vs + (8 * hh + trq) * (VP * 2) + (v0 + 16 * blk + 4 * trp) * 2;
#pragma unroll
      for (int ks = 0; ks < 4; ++ks) vf[ks] = cat8(tr4(vb + (16 * ks) * (VP * 2)), tr4(vb + (16 * ks + 4) * (VP * 2))); }
    f32x16 o[2];
    if (WANT_O) {
#pragma unroll
        for (int tt = 0; tt < 2; ++tt) {
#pragma unroll
            for (int j = 0; j < 16; ++j) o[tt][j] = 0.f;
#pragma unroll
            for (int ks = 0; ks < 4; ++ks) if (tt == 1 || ks < 2) {
                const bf16x8 a = *(const LAS bf16x8*)(P + (32 * tt + r) * PP + 16 * ks + 8 * hh);
                o[tt] = __builtin_amdgcn_mfma_f32_32x32x16_bf16(a, vf[ks], o[tt], 0, 0, 0);
            }
        }
#pragma unroll
        for (int kt = 0; kt < 4; ++kt)
#pragma unroll
            for (int s2 = 0; s2 < 2; ++s2) {
                v4u bw; bw.x = pk2(S[kt][8 * s2 + 0], S[kt][8 * s2 + 1]); bw.y = pk2(S[kt][8 * s2 + 2], S[kt][8 * s2 + 3]);
                bw.z = pk2(S[kt][8 * s2 + 4], S[kt][8 * s2 + 5]); bw.w = pk2(S[kt][8 * s2 + 6], S[kt][8 * s2 + 7]);
                const bf16x8 bfr = __builtin_bit_cast(bf16x8, bw);
#pragma unroll
                for (int tt = 0; tt < 2; ++tt) {
                    const bf16x8 a = *(const LAS bf16x8*)(QE + (32 * tt + r) * QP + 32 * kt + 16 * s2 + 8 * hh);
                    o[tt] = __builtin_amdgcn_mfma_f32_32x32x16_bf16(a, bfr, o[tt], 0, 0, 0);
                }
            }
    }
    { const LAS unsigned char* kb = (const LAS unsigned char*)KX + (8 * hh + trq) * (XP * 2) + (16 * blk + 4 * trp) * 2;
#pragma unroll
      for (int kt = 0; kt < 4; ++kt) {
#pragma unroll
        for (int ks = 0; ks < 4; ++ks) {
            const bf16x8 a = cat8(tr4(kb + (16 * ks) * (XP * 2) + 64 * kt), tr4(kb + (16 * ks + 4) * (XP * 2) + 64 * kt));
            S[kt] = __builtin_amdgcn_mfma_f32_32x32x16_bf16(a, vf[ks], S[kt], 0, 0, 0);
        }
#pragma unroll
        for (int g4 = 0; g4 < 4; ++g4) { const f32x4 d4 = *(const LAS f32x4*)(DKs + 32 * kt + 8 * g4 + 4 * hh);
#pragma unroll
            for (int e = 0; e < 4; ++e) S[kt][4 * g4 + e] *= d4[e]; }
      } }
    if (WANT_O) {
#pragma unroll
        for (int tt = 0; tt < 2; ++tt)
#pragma unroll
            for (int j = 0; j < 16; ++j) OT[(32 * tt + (j & 3) + 8 * (j >> 2) + 4 * hh) * OP + v0 + r] = (bf16)f2bf(o[tt][j]);
        LDS_WAIT(); __builtin_amdgcn_s_barrier(); asm volatile("" ::: "memory");
        const int t = tid >> 3, part = tid & 7;
        v4u ow[4], sw[4]; float q = 0.f;
        const size_t gbase = (size_t)(m0 + t) * GVAL + h * DVH + part * 8;
#pragma unroll
        for (int j = 0; j < 4; ++j) { sw[j] = *(const GAS v4u*)(SRg + gbase + 64 * j); ow[j] = *(const LAS v4u*)(OT + t * OP + part * 8 + 64 * j); }
#pragma unroll
        for (int j = 0; j < 4; ++j) { const float a0 = pg8::bflo(ow[j].x), a1 = pg8::bfhi(ow[j].x), a2 = pg8::bflo(ow[j].y), a3 = pg8::bfhi(ow[j].y), a4 = pg8::bflo(ow[j].z), a5 = pg8::bfhi(ow[j].z), a6 = pg8::bflo(ow[j].w), a7 = pg8::bfhi(ow[j].w);
            q += (a0 * a0 + a1 * a1) + (a2 * a2 + a3 * a3) + (a4 * a4 + a5 * a5) + (a6 * a6 + a7 * a7); }
        q += __shfl_xor(q, 1); q += __shfl_xor(q, 2); q += __shfl_xor(q, 4);
        const float rs = 1.0f / sqrtf(q * (1.f / 256.f) + EPS);
#pragma unroll
        for (int j = 0; j < 4; ++j) { const f32x4 g0 = *(const GAS f32x4*)(gn + h * DVH + part * 8 + 64 * j), g1 = *(const GAS f32x4*)(gn + h * DVH + part * 8 + 64 * j + 4);
            v4u w;
            w.x = pk2(pg8::bflo(ow[j].x) * rs * g0[0] * pg8::bflo(sw[j].x), pg8::bfhi(ow[j].x) * rs * g0[1] * pg8::bfhi(sw[j].x));
            w.y = pk2(pg8::bflo(ow[j].y) * rs * g0[2] * pg8::bflo(sw[j].y), pg8::bfhi(ow[j].y) * rs * g0[3] * pg8::bfhi(sw[j].y));
            w.z = pk2(pg8::bflo(ow[j].z) * rs * g1[0] * pg8::bflo(sw[j].z), pg8::bfhi(ow[j].z) * rs * g1[1] * pg8::bfhi(sw[j].z));
            w.w = pk2(pg8::bflo(ow[j].w) * rs * g1[2] * pg8::bflo(sw[j].w), pg8::bfhi(ow[j].w) * rs * g1[3] * pg8::bfhi(sw[j].w));
            *(GAS v4u*)(OG + gbase + 64 * j) = w; }
    }
}

__device__ __forceinline__ void meta_state(LAS unsigned char* lds, const float* KM, const float* VM, const float* AL, const float* wgu, const float* bgate, int h, f32x16 (&S)[4], int tid, int wid, int lane) {
    LAS float* LM = (LAS float*)lds;
    LAS float* KS = (LAS float*)(lds + 8192);
    const int kc = tid & 127, part = tid >> 7;
#pragma unroll
    for (int i = 0; i < 4; ++i) { const int s = 4 * part + i; float z = bgate[h * DKH + kc];
#pragma unroll
        for (int rr = 0; rr < RANK; ++rr) z += AL[s * RANK + rr] * wgu[rr * GKEY + h * DKH + kc];
        LM[s * 128 + kc] = pg8::logsigf_(z) * 0.0625f; }
    LDS_WAIT(); __syncthreads();
    if (part == 0) { float suf = 0.f;
        for (int s = 15; s >= 0; --s) { KS[s * 128 + kc] = KM[s * GKEY + h * DKH + kc] * __expf(suf); suf += LM[s * 128 + kc]; } }
    LDS_WAIT(); __syncthreads();
    const int r = lane & 31, hh = lane >> 5, v0 = 32 * wid;
    float vm[16];
#pragma unroll
    for (int s = 0; s < 16; ++s) vm[s] = VM[s * GVAL + h * DVH + v0 + r];
#pragma unroll
    for (int kt = 0; kt < 4; ++kt)
#pragma unroll
        for (int j = 0; j < 16; ++j) { const int k = 32 * kt + (j & 3) + 8 * (j >> 2) + 4 * hh; float a = 0.f;
#pragma unroll
            for (int s = 0; s < 16; ++s) a += KS[s * 128 + k] * vm[s];
            S[kt][j] = a; }
    LDS_WAIT(); __syncthreads();
}
}

__global__ void __launch_bounds__(NWAVES * 64, 2) fwd_kernel(Args args) {
    extern __shared__ __attribute__((aligned(16))) unsigned char lds_raw[];
    LAS unsigned char* lds = (LAS unsigned char*)lds_raw;
    volatile LAS unsigned* MISC = (volatile LAS unsigned*)(lds + MISC_OFF);
    const int G = gridDim.x; const int bx = blockIdx.x; const int vcu = (G % 8 == 0) ? (bx % 8) * (G / 8) + bx / 8 : bx;
    const int wave = __builtin_amdgcn_readfirstlane((int)threadIdx.x >> 6);
#define LANE_ID() ((int)__builtin_amdgcn_mbcnt_hi(~0u, __builtin_amdgcn_mbcnt_lo(~0u, 0u)))
#define T0() (wave == 0 && LANE_ID() == 0)
#define PHASE_IDS() int lane_ = LANE_ID(); asm volatile("" : "+v"(lane_)); const int lane = lane_, tid = wave * 64 + lane; const int gw = vcu * NWAVES + wave, NGW = G * NWAVES; (void)tid; (void)gw; (void)NGW
    unsigned char* ws = args.ws;
    unsigned* ctl = (unsigned*)(ws + WS_CTL);
#define INP(i) (args.in[launder_idx(i)])
#define x_in INP(0)
#define meta_tokens INP(1)
#define g_mix_pre INP(2)
#define w_in INP(3)
#define w_gate_up INP(4)
#define b_gate INP(5)
#define gla_norm_g INP(6)
#define w_o_gla INP(7)
#define a_re INP(8)
#define a_im INP(9)
#define log_step INP(10)
#define b_re INP(11)
#define b_im INP(12)
#define c_re INP(13)
#define c_im INP(14)
#define d_skip INP(15)
#define w_glu INP(16)
#define b_glu INP(17)
#define w_out INP(18)
#define g_mix_post INP(19)
#define g_ffn_pre INP(20)
#define w_ff1 INP(21)
#define w_ff2 INP(22)
#define g_ffn_post INP(23)
    float* out = args.out;
    bf16* WT_in = (bf16*)(ws + WS_WIN); bf16* WT_o = (bf16*)(ws + WS_WO); bf16* WT_glu = (bf16*)(ws + WS_WGLU); bf16* WT_out = (bf16*)(ws + WS_WOUT);
    bf16* WT_ff1 = (bf16*)(ws + WS_WFF1); bf16* WT_ff2 = (bf16*)(ws + WS_WFF2); bf16* TZ = (bf16*)(ws + WS_TZ); bf16* MS = (bf16*)(ws + WS_MS);
    bf16* XN = (bf16*)(ws + WS_XN); bf16* OG = XN; bf16* HN = XN;
    bf16* Qb = (bf16*)(ws + WS_Q); bf16* Kb = (bf16*)(ws + WS_K); bf16* Vb = (bf16*)(ws + WS_V); bf16* SR = (bf16*)(ws + WS_SR); bf16* LAb = (bf16*)(ws + WS_LA); bf16* UH = (bf16*)(ws + WS_UH);
    bf16* GS = (bf16*)(ws + WS_GS); bf16* YG = (bf16*)(ws + WS_YG); bf16* MIX = (bf16*)(ws + WS_MIX); float* T1 = (float*)(ws + WS_T);
    bf16* F1 = (bf16*)(ws + WS_F1); float* T2 = (float*)(ws + WS_T2);
    bf16* SZG = (bf16*)out; bf16* SZS = (bf16*)out + (size_t)M * D;
    float* KM = (float*)(ws + WS_SMALL + SM_KM); float* VM = (float*)(ws + WS_SMALL + SM_VM); float* AL = (float*)(ws + WS_SMALL + SM_AL);
    float* UM = (float*)(ws + WS_SMALL + SM_UM); float* L16 = (float*)(ws + WS_SMALL + SM_L16);
    float* DS = (float*)(ws + WS_DS); float* DD = (float*)(ws + WS_DS + 32 * MiB);

    for (int u = wave * 64 + LANE_ID(); u < (LDS_BYTES - LDSCTL_OFF) / 4; u += NWAVES * 64) ((LAS unsigned*)(lds + LDSCTL_OFF))[u] = 0u;
    __syncthreads();
    XcdBarrier bar; bar.bar = ctl + CW_BAR; bar.x = 0; bar.st = nullptr;
    if (N_LAUNCHES == 1) bar = xcd_barrier_post(ctl + CW_BAR, MISC + 8, T0());
    const int lo = args.ph_lo, hi = args.ph_hi;
#define IN(k) (lo <= (k) && (k) < hi)
#define SEAM(k) do { if (IN(k) && IN((k) + 1)) xcd_barrier(bar, T0()); } while (0)

    if (IN(0)) for (int rep_ = 0; rep_ <= ((PROBE_REP_MASK >> 0) & 1); ++rep_) {
        PHASE_IDS();
        if (vcu < 41) {
            LAS float* XNM = (LAS float*)lds;
            LAS float* PART = (LAS float*)(lds + 65536);
#pragma unroll
            for (int rr = 0; rr < 2; ++rr) { const int row = 2 * wave + rr;
                const GAS f32x4* xr = (const GAS f32x4*)(meta_tokens + (size_t)row * D) + lane; const GAS f32x4* gr = (const GAS f32x4*)g_mix_pre + lane;
                f32x4 v[4]; float s = 0.f;
#pragma unroll
                for (int j = 0; j < 4; ++j) { v[j] = xr[64 * j]; s += (v[j].x * v[j].x + v[j].y * v[j].y) + (v[j].z * v[j].z + v[j].w * v[j].w); }
                const float rs = 1.0f / sqrtf(wave_sum(s) * (1.f / 1024.f) + EPS);
#pragma unroll
                for (int j = 0; j < 4; ++j) { const f32x4 g = gr[64 * j]; *(LAS f32x4*)(XNM + row * 1024 + 4 * lane + 256 * j) = (f32x4){v[j].x * rs * g.x, v[j].y * rs * g.y, v[j].z * rs * g.z, v[j].w * rs * g.w}; } }
            LDS_WAIT(); __syncthreads();
            const int it = vcu; int src, ncol; float* dst; int dld, dcol;
            if (it < 8)       { src = 512 + 64 * it;          ncol = 64; dst = KM; dld = 512;  dcol = 64 * it; }
            else if (it < 24) { src = 1024 + 64 * (it - 8);   ncol = 64; dst = VM; dld = 1024; dcol = 64 * (it - 8); }
            else if (it == 24){ src = SRC_A;                  ncol = 16; dst = AL; dld = 16;   dcol = 0; }
            else              { src = SRC_U + 64 * (it - 25); ncol = 64; dst = UM; dld = 1024; dcol = 64 * (it - 25); }
            float acc[16];
#pragma unroll
            for (int rr = 0; rr < 16; ++rr) acc[rr] = 0.f;
            const bool colok = lane < ncol;
            for (int k4 = 0; k4 < 32; ++k4) { const int k = 128 * wave + 4 * k4;
                float wv[4];
#pragma unroll
                for (int e = 0; e < 4; ++e) wv[e] = colok ? w_in[(size_t)(k + e) * IN_W + src + lane] : 0.f;
#pragma unroll
                for (int rr = 0; rr < 16; ++rr) { const f32x4 xv = *(const LAS f32x4*)(XNM + rr * 1024 + k); acc[rr] += (xv.x * wv[0] + xv.y * wv[1]) + (xv.z * wv[2] + xv.w * wv[3]); } }
#pragma unroll
            for (int rr = 0; rr < 16; ++rr) PART[(wave * 16 + rr) * 64 + lane] = acc[rr];
            LDS_WAIT(); __syncthreads();
#pragma unroll
            for (int e = 0; e < 2; ++e) { const int idx = tid + 512 * e, rr = idx >> 6, col = idx & 63; float s = 0.f;
#pragma unroll
                for (int w = 0; w < 8; ++w) s += PART[(w * 16 + rr) * 64 + col];
                if (col < ncol) dst[rr * dld + dcol + col] = s; }
            LDS_WAIT(); __syncthreads();
        }
        LAS float* scr = (LAS float*)(lds + wave * 16384);
        constexpr int I_IN = 192 * 16, I_O = 32 * 16, I_GLU = 64 * 16, I_OUT = 32 * 16, I_FF1 = 128 * 16, I_FF2 = 32 * 64;
        constexpr int I_WA = 8 * 128, I_SSM = 64 * 16, I_XN = M;
        constexpr int NITEMS = I_IN + I_O + I_GLU + I_OUT + I_FF1 + I_FF2 + I_WA + I_SSM + I_XN;
        for (int it = gw; it < NITEMS; it += NGW) {
            int r = it;
            if (r < I_IN) { const int rb = r >> 4, kb = r & 15, d0 = 32 * rb; p0_transpose_item(w_in, IN_W, d0 < 3072 ? d0 : d0 + 16, D, WT_in, d0, scr, kb, lane); continue; } r -= I_IN;
            if (r < I_O) { const int rb = r >> 4, kb = r & 15; p0_transpose_item(w_o_gla, D, 32 * rb, GVAL, WT_o, 32 * rb, scr, kb, lane); continue; } r -= I_O;
            if (r < I_GLU) { const int rb = r >> 4, kb = r & 15, d0 = 32 * rb, pn = d0 >> 8, wi = d0 & 255;
                p0_transpose_item(w_glu, 2 * D, wi < 128 ? 128 * pn + wi : 1024 + 128 * pn + (wi - 128), D, WT_glu, d0, scr, kb, lane); continue; } r -= I_GLU;
            if (r < I_OUT) { const int rb = r >> 4, kb = r & 15; p0_transpose_item(w_out, D, 32 * rb, D, WT_out, 32 * rb, scr, kb, lane); continue; } r -= I_OUT;
            if (r < I_FF1) { const int rb = r >> 4, kb = r & 15; p0_transpose_item(w_ff1, FF, 32 * rb, D, WT_ff1, 32 * rb, scr, kb, lane); continue; } r -= I_FF1;
            if (r < I_FF2) { const int rb = r >> 6, kb = r & 63; p0_transpose_item(w_ff2, D, 32 * rb, FF, WT_ff2, 32 * rb, scr, kb, lane); continue; } r -= I_FF2;
            if (r < I_WA) {
                const int nb = r >> 7, kb = r & 127, n = 64 * nb + lane;
                float wg[16];
#pragma unroll
                for (int rr = 0; rr < 16; ++rr) wg[rr] = w_gate_up[rr * GKEY + n];
                float o8[8];
#pragma unroll
                for (int e = 0; e < 8; ++e) { const float* wr_ = w_in + (size_t)(8 * kb + e) * IN_W + SRC_A; float s = 0.f;
#pragma unroll
                    for (int rr = 0; rr < 16; ++rr) s += wr_[rr] * wg[rr];
                    o8[e] = s; }
                *(GAS v4u*)(WT_in + (size_t)(6144 + n) * D + 8 * kb) = (v4u){pk2(o8[0], o8[1]), pk2(o8[2], o8[3]), pk2(o8[4], o8[5]), pk2(o8[6], o8[7])};
                continue; } r -= I_WA;
            if (r < I_SSM) {
                const int g = r >> 4, d = r & 15, n = lane;
                LAS float* BBr = scr;
                LAS float* BBi = scr + 1024;
                LAS float* LDr = scr + 2048;
                LAS float* LDi = scr + 2112;
                const float ar = a_re[g * SN + n], ai = a_im[g * SN + n], dt = expf(log_step[g]);
                const float mag = expf(ar * dt), lr = mag * cosf(ai * dt), li = mag * sinf(ai * dt);
                const float zr = lr - 1.0f, zi = li, den = ar * ar + ai * ai, fre = (zr * ar + zi * ai) / den, fim = (zi * ar - zr * ai) / den;
                float bbr[16], bbi[16];
#pragma unroll
                for (int j = 0; j < 16; ++j) { const float br = b_re[(g * SN + n) * SHG + j], bi = b_im[(g * SN + n) * SHG + j];
                    bbr[j] = fre * br - fim * bi; bbi[j] = fre * bi + fim * br; BBr[n * 16 + j] = bbr[j]; BBi[n * 16 + j] = bbi[j]; }
                auto powl = [&](int p) { const float mg = expf((float)p * (ar * dt)), an = (float)p * (ai * dt); return cpx{mg * cosf(an), mg * sinf(an)}; };
                const cpx wd = powl(d), wd1 = powl(d + 1), w15 = powl(15 - d);
                LDr[n] = wd.r; LDi[n] = wd.i;
                LDS_WAIT(); asm volatile("" ::: "memory");
                {
                    const int i = lane >> 2, j0 = (lane & 3) * 4; float a4[4] = {0.f, 0.f, 0.f, 0.f};
                    for (int nn = 0; nn < SN; ++nn) { const cpx c = cpx{c_re[(g * SHG + i) * SN + nn], c_im[(g * SHG + i) * SN + nn]}; const cpx cw = cmul(c, cpx{LDr[nn], LDi[nn]});
#pragma unroll
                        for (int e = 0; e < 4; ++e) a4[e] += cw.r * BBr[nn * 16 + j0 + e] - cw.i * BBi[nn * 16 + j0 + e]; }
                    if (d == 0) {
#pragma unroll
                        for (int e = 0; e < 4; ++e) if (i == j0 + e) a4[e] += d_skip[g * SHG + i]; }
                    const v2u val = (v2u){pk2(a4[0], a4[1]), pk2(a4[2], a4[3])}, zero = (v2u){0u, 0u};
                    for (int t = d; t < 16; ++t) *(GAS v2u*)(TZ + (size_t)(g * 256 + 16 * t + i) * 384 + 16 * (t - d) + j0) = val;
                    if (d >= 1) for (int t = 0; t + d < 16; ++t) *(GAS v2u*)(TZ + (size_t)(g * 256 + 16 * t + i) * 384 + 16 * (t + d) + j0) = zero;
                }
                for (int i = 0; i < 16; ++i) { const cpx c = cpx{c_re[(g * SHG + i) * SN + n], c_im[(g * SHG + i) * SN + n]}; const cpx cl = cmul(c, wd1);
                    TZ[(size_t)(g * 256 + 16 * d + i) * 384 + 256 + n] = (bf16)f2bf(cl.r); TZ[(size_t)(g * 256 + 16 * d + i) * 384 + 320 + n] = (bf16)f2bf(-cl.i); }
                { unsigned pr[8], pi[8];
#pragma unroll
                    for (int j = 0; j < 16; j += 2) { const cpx v0 = cmul(w15, cpx{bbr[j], bbi[j]}), v1 = cmul(w15, cpx{bbr[j + 1], bbi[j + 1]}); pr[j >> 1] = pk2(v0.r, v1.r); pi[j >> 1] = pk2(v0.i, v1.i); }
                    GAS v4u* p0 = (GAS v4u*)(MS + (size_t)(g * 128 + n) * 256 + 16 * d); p0[0] = (v4u){pr[0], pr[1], pr[2], pr[3]}; p0[1] = (v4u){pr[4], pr[5], pr[6], pr[7]};
                    GAS v4u* p1 = (GAS v4u*)(MS + (size_t)(g * 128 + 64 + n) * 256 + 16 * d); p1[0] = (v4u){pi[0], pi[1], pi[2], pi[3]}; p1[1] = (v4u){pi[4], pi[5], pi[6], pi[7]}; }
                if (d == 0) { const cpx w16 = powl(16); L16[(g * SN + n) * 2] = w16.r; L16[(g * SN + n) * 2 + 1] = w16.i; }
                LDS_WAIT(); asm volatile("" ::: "memory");
                continue; } r -= I_SSM;
            rms_row_to_bf16(x_in + (size_t)r * D, g_mix_pre, XN + (size_t)r * D, lane);
        }
    }
    SEAM(0);

    if (IN(1)) for (int rep_ = 0; rep_ <= ((PROBE_REP_MASK >> 1) & 1); ++rep_) {
        pg8::Gemm g{XN, WT_in, D, D, D, 256}; pg8::StaticOrder S; S.init(M, NIN, G, bx);
        pg8::EpiIn E{Qb, Kb, Vb, SR, UH, SZG, SZS, LAb, b_gate};
        pg8::gemm_phase<pg8::EpiIn, pg8::StaticOrder, true>(lds, g, S, E, wave);
    }
    SEAM(1);

    if (IN(2)) for (int rep_ = 0; rep_ <= ((PROBE_REP_MASK >> 2) & 1); ++rep_) {
        { pg8::Gemm g{UH, MS, 384, 256, 256, 128}; pg8::GroupOrder S{G, bx};
          pg8::EpiE E{UH};
          pg8::gemm_phase<pg8::EpiE, pg8::GroupOrder, true>(lds, g, S, E, wave); }
        PHASE_IDS();
        { const int u = vcu & 255, bh = u >> 3, seg = u & 7;
            if (seg < 7) {
                const int b = bh >> 2, h = bh & 3, mf = b * SEQ + seg * 512;
                f32x16 S[4];
#pragma unroll
                for (int kt = 0; kt < 4; ++kt)
#pragma unroll
                    for (int j = 0; j < 16; ++j) S[kt][j] = 0.f;
                float dsum = 0.f; gla::Pref pf;
                gla::prefetch<false>(pf, Qb, Kb, LAb, Vb, mf, h, tid);
                for (int c = 0; c < 8; ++c)
                    gla::chunk<false>(lds, Qb, Kb, LAb, Vb, SR, nullptr, OG, mf + 64 * c, c < 7 ? mf + 64 * (c + 1) : -1, h, S, pf, dsum, tid, wave, lane);
                float* ds = DS + (size_t)(bh * 7 + seg) * (16 * 2048);
#pragma unroll
                for (int kt = 0; kt < 4; ++kt)
#pragma unroll
                    for (int g4 = 0; g4 < 4; ++g4) *(GAS f32x4*)(ds + ((kt * 4 + g4) * 512 + tid) * 4) = (f32x4){S[kt][4 * g4], S[kt][4 * g4 + 1], S[kt][4 * g4 + 2], S[kt][4 * g4 + 3]};
                if (tid < 128) DD[(bh * 7 + seg) * 128 + tid] = dsum;
            }
        }
        __syncthreads();
    }
    SEAM(2);

    if (IN(3)) {
        PHASE_IDS();
        {
            LAS bf16* EL = (LAS bf16*)lds;
#pragma unroll
            for (int pp = 0; pp < 2; ++pp) { const int p = (2 * vcu + pp) & 511, b = p >> 6, g = p & 63; const bf16* src = UH + (size_t)(g * 2048 + b * 256) * 384 + 256;
                for (int idx = tid; idx < 256 * 16; idx += 512) { const int c = idx >> 4, pc = idx & 15; *(LAS v4u*)(EL + (pp * 256 + c) * 128 + pc * 8) = *(const GAS v4u*)(src + (size_t)c * 384 + pc * 8); } }
            LDS_WAIT(); __syncthreads();
            if (wave < 2) {
                const int p = (2 * vcu + wave) & 511, g = p & 63, n = lane;
                float hr = 0.f, hi_ = 0.f;
                {
                    const bf16* m0p = MS + (size_t)(g * 128 + n) * 256; const bf16* m1p = MS + (size_t)(g * 128 + 64 + n) * 256;
                    for (int kb = 0; kb < 32; ++kb) { const v4u a = *(const GAS v4u*)(m0p + 8 * kb), c4 = *(const GAS v4u*)(m1p + 8 * kb);
                        const float* up = UM + (kb >> 1) * D + g * SHG + (kb & 1) * 8;
                        const f32x4 u0 = *(const GAS f32x4*)up, u1 = *(const GAS f32x4*)(up + 4);
                        hr += (pg8::bflo(a.x) * u0[0] + pg8::bfhi(a.x) * u0[1]) + (pg8::bflo(a.y) * u0[2] + pg8::bfhi(a.y) * u0[3]) + (pg8::bflo(a.z) * u1[0] + pg8::bfhi(a.z) * u1[1]) + (pg8::bflo(a.w) * u1[2] + pg8::bfhi(a.w) * u1[3]);
                        hi_ += (pg8::bflo(c4.x) * u0[0] + pg8::bfhi(c4.x) * u0[1]) + (pg8::bflo(c4.y) * u0[2] + pg8::bfhi(c4.y) * u0[3]) + (pg8::bflo(c4.z) * u1[0] + pg8::bfhi(c4.z) * u1[1]) + (pg8::bflo(c4.w) * u1[2] + pg8::bfhi(c4.w) * u1[3]); }
                }
                const float lr = L16[(g * SN + n) * 2], li = L16[(g * SN + n) * 2 + 1];
                LAS bf16* el = EL + wave * 256 * 128 + n;
#pragma unroll 8
                for (int c = 0; c < 256; ++c) { const float er = bf2f(el[c * 128]), ei = bf2f(el[c * 128 + 64]);
                    el[c * 128] = (bf16)f2bf(hr); el[c * 128 + 64] = (bf16)f2bf(hi_);
                    const float nr = lr * hr - li * hi_ + er, ni = lr * hi_ + li * hr + ei; hr = nr; hi_ = ni; }
            }
            LDS_WAIT(); __syncthreads();
#pragma unroll
            for (int pp = 0; pp < 2; ++pp) { const int p = (2 * vcu + pp) & 511, b = p >> 6, g = p & 63; bf16* dst = UH + (size_t)(g * 2048 + b * 256) * 384 + 256;
                for (int idx = tid; idx < 256 * 16; idx += 512) { const int c = idx >> 4, pc = idx & 15; *(GAS v4u*)(dst + (size_t)c * 384 + pc * 8) = *(const LAS v4u*)(EL + (pp * 256 + c) * 128 + pc * 8); } }
            LDS_WAIT(); __syncthreads();
        }
        for (int rep_ = 0; rep_ <= ((PROBE_REP_MASK >> 3) & 1); ++rep_)
        { const int u = vcu & 255, bh = u >> 3, seg = u & 7, b = bh >> 2, h = bh & 3, mf = b * SEQ + seg * 512;
            for (int i = tid; i < 64 * gla::PP / 2; i += 512) ((LAS unsigned*)(lds + gla::O_P))[i] = 0u;
            f32x16 S[4];
            gla::meta_state(lds, KM, VM, AL, w_gate_up, b_gate, h, S, tid, wave, lane);
            for (int j = 0; j < seg; ++j) {
                const float* ds = DS + (size_t)(bh * 7 + j) * (16 * 2048); const float* dd = DD + (bh * 7 + j) * 128;
#pragma unroll
                for (int kt = 0; kt < 4; ++kt)
#pragma unroll
                    for (int g4 = 0; g4 < 4; ++g4) { const f32x4 a = *(const GAS f32x4*)(ds + ((kt * 4 + g4) * 512 + tid) * 4), d4 = *(const GAS f32x4*)(dd + 32 * kt + 8 * g4 + 4 * (lane >> 5));
#pragma unroll
                        for (int e = 0; e < 4; ++e) S[kt][4 * g4 + e] = __expf(d4[e]) * S[kt][4 * g4 + e] + a[e]; }
            }
            float dsum = 0.f; gla::Pref pf;
            gla::prefetch<true>(pf, Qb, Kb, LAb, Vb, mf, h, tid);
            for (int c = 0; c < 8; ++c)
                gla::chunk<true>(lds, Qb, Kb, LAb, Vb, SR, gla_norm_g, OG, mf + 64 * c, c < 7 ? mf + 64 * (c + 1) : -1, h, S, pf, dsum, tid, wave, lane);
            __syncthreads();
        }
    }
    SEAM(3);

    if (IN(4)) for (int rep_ = 0; rep_ <= ((PROBE_REP_MASK >> 4) & 1); ++rep_) {
        { pg8::Gemm g{UH, TZ, 384, 384, 384, 256}; pg8::GroupOrder S{G, bx}; pg8::EpiS E{GS};
          pg8::gemm_phase<pg8::EpiS, pg8::GroupOrder, true>(lds, g, S, E, wave); }
        { pg8::Gemm g{OG, WT_o, D, D, D, 256}; pg8::StaticOrder S; S.init(M, D, G, bx); pg8::EpiYG E{SZG, YG};
          pg8::gemm_phase<pg8::EpiYG, pg8::StaticOrder, true>(lds, g, S, E, wave); }
    }
    SEAM(4);

    if (IN(5)) for (int rep_ = 0; rep_ <= ((PROBE_REP_MASK >> 5) & 1); ++rep_) {
        pg8::Gemm g{GS, WT_glu, D, D, D, 256}; pg8::StaticOrder S; S.init(M, 2 * D, G, bx); pg8::EpiGlu E{YG, SZS, MIX, b_glu};
        pg8::gemm_phase<pg8::EpiGlu, pg8::StaticOrder, true>(lds, g, S, E, wave);
    }
    SEAM(5);

    if (IN(6)) for (int rep_ = 0; rep_ <= ((PROBE_REP_MASK >> 6) & 1); ++rep_) {
        pg8::Gemm g{MIX, WT_out, D, D, D, 256}; pg8::StaticOrder S; S.init(M, D, G, bx); pg8::EpiF32 E{T1, D};
        pg8::gemm_phase<pg8::EpiF32, pg8::StaticOrder, true>(lds, g, S, E, wave);
    }
    SEAM(6);

    if (IN(7)) for (int rep_ = 0; rep_ <= ((PROBE_REP_MASK >> 7) & 1); ++rep_) {
        PHASE_IDS();
        for (int m = gw; m < M; m += NGW) {
            const GAS f32x4* tr = (const GAS f32x4*)(T1 + (size_t)m * D) + lane; const GAS f32x4* xr = (const GAS f32x4*)(x_in + (size_t)m * D) + lane;
            const GAS f32x4* g1 = (const GAS f32x4*)g_mix_post + lane; const GAS f32x4* g2 = (const GAS f32x4*)g_ffn_pre + lane;
            f32x4 v[4]; float s = 0.f;
#pragma unroll
            for (int j = 0; j < 4; ++j) { v[j] = tr[64 * j]; s += (v[j].x * v[j].x + v[j].y * v[j].y) + (v[j].z * v[j].z + v[j].w * v[j].w); }
            const float rs = 1.0f / sqrtf(wave_sum(s) * (1.f / 1024.f) + EPS); float s2 = 0.f;
#pragma unroll
            for (int j = 0; j < 4; ++j) { const f32x4 g = g1[64 * j], xv = xr[64 * j]; v[j] = (f32x4){xv.x + v[j].x * rs * g.x, xv.y + v[j].y * rs * g.y, xv.z + v[j].z * rs * g.z, xv.w + v[j].w * rs * g.w};
                s2 += (v[j].x * v[j].x + v[j].y * v[j].y) + (v[j].z * v[j].z + v[j].w * v[j].w);
                *((GAS f32x4*)(out + (size_t)m * D) + lane + 64 * j) = v[j]; }
            const float rs2 = 1.0f / sqrtf(wave_sum(s2) * (1.f / 1024.f) + EPS);
            GAS unsigned long long* o8 = (GAS unsigned long long*)(HN + (size_t)m * D) + lane;
#pragma unroll
            for (int j = 0; j < 4; ++j) { const f32x4 g = g2[64 * j];
                o8[64 * j] = (unsigned long long)pk2(v[j].x * rs2 * g.x, v[j].y * rs2 * g.y) | ((unsigned long long)pk2(v[j].z * rs2 * g.z, v[j].w * rs2 * g.w) << 32); }
        }
    }
    SEAM(7);

    if (IN(8)) for (int rep_ = 0; rep_ <= ((PROBE_REP_MASK >> 8) & 1); ++rep_) {
        pg8::Gemm g{HN, WT_ff1, D, D, D, 256}; pg8::StaticOrder S; S.init(M, FF, G, bx); pg8::EpiRelu2 E{F1, FF};
        pg8::gemm_phase<pg8::EpiRelu2, pg8::StaticOrder, true>(lds, g, S, E, wave);
    }
    SEAM(8);

    if (IN(9)) for (int rep_ = 0; rep_ <= ((PROBE_REP_MASK >> 9) & 1); ++rep_) {
        pg8::Gemm g{F1, WT_ff2, FF, FF, FF, 256}; pg8::StaticOrder S; S.init(M, D, G, bx); pg8::EpiF32 E{T2, D};
        pg8::gemm_phase<pg8::EpiF32, pg8::StaticOrder, true>(lds, g, S, E, wave);
    }
    SEAM(9);

    if (IN(10)) {
        PHASE_IDS();
        for (int m = gw; m < M; m += NGW) {
            const GAS f32x4* tr = (const GAS f32x4*)(T2 + (size_t)m * D) + lane; GAS f32x4* orow = (GAS f32x4*)(out + (size_t)m * D) + lane;
            const GAS f32x4* g1 = (const GAS f32x4*)g_ffn_post + lane;
            f32x4 v[4]; float s = 0.f;
#pragma unroll
            for (int j = 0; j < 4; ++j) { v[j] = tr[64 * j]; s += (v[j].x * v[j].x + v[j].y * v[j].y) + (v[j].z * v[j].z + v[j].w * v[j].w); }
            const float rs = 1.0f / sqrtf(wave_sum(s) * (1.f / 1024.f) + EPS);
#pragma unroll
            for (int j = 0; j < 4; ++j) { const f32x4 g = g1[64 * j], hv = orow[64 * j];
                orow[64 * j] = (f32x4){hv.x + v[j].x * rs * g.x, hv.y + v[j].y * rs * g.y, hv.z + v[j].z * rs * g.z, hv.w + v[j].w * rs * g.w}; }
        }
    }
#undef IN
#undef SEAM
#undef x_in
#undef meta_tokens
#undef g_mix_pre
#undef w_in
#undef w_gate_up
#undef b_gate
#undef gla_norm_g
#undef w_o_gla
#undef a_re
#undef a_im
#undef log_step
#undef b_re
#undef b_im
#undef c_re
#undef c_im
#undef d_skip
#undef w_glu
#undef b_glu
#undef w_out
#undef g_mix_post
#undef g_ffn_pre
#undef w_ff1
#undef w_ff2
#undef g_ffn_post
}

extern "C" void kernel_launch(void* const* d_in, const int* in_sizes, int n_in, void* d_out, int out_size, void* d_ws, size_t ws_size, hipStream_t stream) {
    static int grid = 0;
    if (grid == 0) {
        if (n_in != 24 || in_sizes[0] != M * D || out_size != M * D || ws_size < WS_END) { fprintf(stderr, "kernel_launch: unexpected shapes (n_in %d, in0 %d, out %d, ws %zu)\n", n_in, n_in > 0 ? in_sizes[0] : -1, out_size, ws_size); grid = -1; return; }
        int dev = 0, cus = 0;
        if (hipGetDevice(&dev) != hipSuccess || hipDeviceGetAttribute(&cus, hipDeviceAttributeMultiprocessorCount, dev) != hipSuccess) { grid = -1; return; }
        if (hipFuncSetAttribute((const void*)fwd_kernel, hipFuncAttributeMaxDynamicSharedMemorySize, LDS_BYTES) != hipSuccess) { fprintf(stderr, "kernel_launch: hipFuncSetAttribute failed\n"); grid = -1; return; }
        int per_cu = 0;
        if (hipOccupancyMaxActiveBlocksPerMultiprocessor(&per_cu, (const void*)fwd_kernel, NWAVES * 64, LDS_BYTES) != hipSuccess || per_cu < 1) fprintf(stderr, "kernel_launch: occupancy query says %d\n", per_cu);
        (void)hipGetLastError();
        if (cus < 256) { fprintf(stderr, "kernel_launch: this kernel needs 256 CUs (one resident workgroup each), device has %d\n", cus); grid = -1; return; }
        grid = 256;
    }
    if (grid < 0) return;
    if (hipMemsetAsync((char*)d_ws + WS_CTL, 0, CTL_ZERO_BYTES, stream) != hipSuccess) return;
    Args a{};
    for (int i = 0; i < 24; ++i) a.in[i] = (const float*)d_in[i];
    a.out = (float*)d_out; a.ws = (unsigned char*)d_ws;
    if (N_LAUNCHES == 1) {
        a.ph_lo = 0; a.ph_hi = N_PHASES; a.li = 0;
        hipLaunchKernelGGL(fwd_kernel, dim3(grid), dim3(NWAVES * 64), LDS_BYTES, stream, a);
    } else {
        for (int li = 0; li < N_PHASES; ++li) { a.ph_lo = li; a.ph_hi = li + 1; a.li = li;
            hipLaunchKernelGGL(fwd_kernel, dim3(grid), dim3(NWAVES * 64), LDS_BYTES, stream, a); }
    }
}
```

```cpp
#include <hip/hip_runtime.h>
#include <cstdio>
#include <cstdint>

#ifndef PROBE_REP_MASK
#define PROBE_REP_MASK 0
#endif
#ifndef MK_N_LAUNCHES
#define MK_N_LAUNCHES 1
#endif

namespace pg8 {
#define PG8_LAS __attribute__((address_space(3)))
typedef unsigned short bf16_t;
typedef short bf16x8 __attribute__((ext_vector_type(8)));
typedef float f32x4 __attribute__((ext_vector_type(4)));
typedef float f32x2 __attribute__((ext_vector_type(2)));
typedef unsigned u32x4 __attribute__((ext_vector_type(4)));
constexpr int BM = 256, BK = 64, HALF = 128, HTB = HALF * BK * 2, STAGE_BYTES = 8 * HTB, NXCD = 8, WGM = 8;

__host__ __device__ __forceinline__ int lds_byte(int r, int c) { const int st = (r >> 4) * 2 + (c >> 5), rr = r & 15, cc = c & 31, ob = rr * 64 + cc * 2; return st * 1024 + (ob ^ (((ob >> 9) & 1) << 5)); }
__host__ __device__ __forceinline__ void stage_rc(int b, int& R, int& C) { const int st = b / 1024, sb = b % 1024, swz = sb ^ (((sb >> 9) & 1) << 5); R = (st >> 1) * 16 + swz / 64; C = (st & 1) * 32 + (swz % 64) / 2; }
__host__ __device__ __forceinline__ int perm32(int rho) { const int n = rho >> 4, i = rho & 15; return 8 * (i >> 2) + 4 * n + (i & 3); }

struct Unit { int pm, pn; };
struct Gemm { const bf16_t* A; const bf16_t* Bt; int lda, ldb, K, tstepB_rows; };

struct StaticOrder {
    int nM, nN, nwg, G, c;
    __host__ __device__ void init(int M, int N, int G_, int c_) { nM = M / BM; nN = N / BM; nwg = nM * nN; G = G_; c = c_; }
    __host__ __device__ bool next(int i, Unit& u) const {
        const long L = (long)i * G + c; if (L >= nwg) return false;
        int wgid = (int)L; { const int q = nwg / NXCD, r = nwg % NXCD, xcd = wgid % NXCD, off = wgid / NXCD; wgid = (xcd < r ? xcd * (q + 1) : r * (q + 1) + (xcd - r) * q) + off; }
        const int nig = WGM * nN, gid = wgid / nig, fm = gid * WGM, gsz = (nM - fm) < WGM ? (nM - fm) : WGM;
        u.pm = fm + ((wgid % nig) % gsz); u.pn = (wgid % nig) / gsz; return true;
    }
};
struct GroupOrder {
    int G, c;
    __host__ __device__ bool next(int i, Unit& u) const { const int L = i * G + c; if (L >= 512) return false; u.pm = L; u.pn = L >> 3; return true; }
};

__device__ __forceinline__ unsigned cvt_pk_bf16(float lo, float hi) { unsigned r; asm volatile("v_cvt_pk_bf16_f32 %0, %1, %2" : "=v"(r) : "v"(lo), "v"(hi)); return r; }
__device__ __forceinline__ float bflo(unsigned w) { return __uint_as_float(w << 16); }
__device__ __forceinline__ float bfhi(unsigned w) { return __uint_as_float(w & 0xffff0000u); }
__device__ __forceinline__ float sigmoidf_(float x) { return __builtin_amdgcn_rcpf(1.0f + __expf(-x)); }
__device__ __forceinline__ float logsigf_(float x) { return fminf(x, 0.f) - log1pf(__expf(-fabsf(x))); }
__device__ __forceinline__ float gelu_tanh(float x) { const float z = 0.7978845608028654f * (x + 0.044715f * x * x * x); return x * __builtin_amdgcn_rcpf(1.0f + __expf(-2.0f * z)); }
__device__ __forceinline__ u32x4 pack8(const f32x4& a, const f32x4& b) { u32x4 w; w.x = cvt_pk_bf16(a[0], a[1]); w.y = cvt_pk_bf16(a[2], a[3]); w.z = cvt_pk_bf16(b[0], b[1]); w.w = cvt_pk_bf16(b[2], b[3]); return w; }

struct EpiF32 {
    static constexpr bool PERM = false;
    float* C; int ldc;
    __device__ __forceinline__ void operator()(const f32x4 (&acc)[2][2][4][2], const Unit& u, int wr, int wc, int fr, int fq) const {
        const int row0 = u.pm * BM + wr * 64 + fr, col0 = u.pn * BM + wc * 32 + 4 * fq;
#pragma unroll
        for (int ai = 0; ai < 2; ++ai)
#pragma unroll
            for (int m = 0; m < 4; ++m) { float* rowp = C + (size_t)(row0 + ai * HALF + m * 16) * ldc + col0;
#pragma unroll
                for (int bj = 0; bj < 2; ++bj)
#pragma unroll
                    for (int n = 0; n < 2; ++n) *(f32x4*)(rowp + bj * HALF + n * 16) = acc[ai][bj][m][n]; }
    }
};
struct EpiIn {
    static constexpr bool PERM = true;
    bf16_t *Q, *K, *V, *SR, *UH, *SZG, *SZS, *LA; const float* b_gate;
    template <int KIND>
    __device__ __forceinline__ void run(const f32x4 (&acc)[2][2][4][2], bf16_t* base, int ld, int row0, int col0) const {
#pragma unroll
        for (int bj = 0; bj < 2; ++bj) {
            const int c = col0 + bj * HALF;
            f32x4 b0 = (f32x4){0.f, 0.f, 0.f, 0.f}, b1 = b0;
            if (KIND == 5) { b0 = *(const f32x4*)(b_gate + c); b1 = *(const f32x4*)(b_gate + c + 4); }
#pragma unroll
            for (int ai = 0; ai < 2; ++ai)
#pragma unroll
                for (int m = 0; m < 4; ++m) {
                    const int row = row0 + ai * HALF + m * 16;
                    f32x4 v0 = acc[ai][bj][m][0], v1 = acc[ai][bj][m][1];
                    if (KIND == 0) { v0 = v0 * 0.08838834764831845f; v1 = v1 * 0.08838834764831845f; }
                    if (KIND == 2) {
#pragma unroll
                        for (int j = 0; j < 4; ++j) { v0[j] = v0[j] * sigmoidf_(v0[j]); v1[j] = v1[j] * sigmoidf_(v1[j]); } }
                    if (KIND == 4) {
#pragma unroll
                        for (int j = 0; j < 4; ++j) { v0[j] = sigmoidf_(v0[j]); v1[j] = sigmoidf_(v1[j]); } }
                    if (KIND == 5) {
#pragma unroll
                        for (int j = 0; j < 4; ++j) { v0[j] = logsigf_(v0[j] + b0[j]) * 0.0625f; v1[j] = logsigf_(v1[j] + b1[j]) * 0.0625f; } }
                    bf16_t* p = (KIND == 3) ? base + ((size_t)((c >> 4) * 2048 + (row >> 4)) * 384 + (row & 15) * 16 + (c & 15))
                                            : base + ((size_t)row * ld + c);
                    *(u32x4*)p = pack8(v0, v1);
                }
        }
    }
    __device__ __forceinline__ void operator()(const f32x4 (&acc)[2][2][4][2], const Unit& u, int wr, int wc, int fr, int fq) const {
        const int pn = u.pn; const int row0 = u.pm * BM + wr * 64 + fr, cw = wc * 32 + 8 * fq;
        if (pn < 2)       run<0>(acc, Q, 512, row0, pn * 256 + cw);
        else if (pn < 4)  run<1>(acc, K, 512, row0, (pn - 2) * 256 + cw);
        else if (pn < 8)  run<1>(acc, V, 1024, row0, (pn - 4) * 256 + cw);
        else if (pn < 12) run<2>(acc, SR, 1024, row0, (pn - 8) * 256 + cw);
        else if (pn < 16) run<3>(acc, UH, 0, row0, (pn - 12) * 256 + cw);
        else if (pn < 20) run<4>(acc, SZG, 1024, row0, (pn - 16) * 256 + cw);
        else if (pn < 24) run<4>(acc, SZS, 1024, row0, (pn - 20) * 256 + cw);
        else              run<5>(acc, LA, 512, row0, (pn - 24) * 256 + cw);
    }
};
struct EpiE {
    static constexpr bool PERM = true;
    bf16_t* UH;
    __device__ __forceinline__ void operator()(const f32x4 (&acc)[2][2][4][2], const Unit& u, int wr, int wc, int fr, int fq) const {
        const int row0 = u.pm * BM + wr * 64 + fr, col0 = 256 + wc * 32 + 8 * fq;
#pragma unroll
        for (int ai = 0; ai < 2; ++ai)
#pragma unroll
            for (int m = 0; m < 4; ++m) *(u32x4*)(UH + (size_t)(row0 + ai * HALF + m * 16) * 384 + col0) = pack8(acc[ai][0][m][0], acc[ai][0][m][1]);
    }
};
struct EpiS {
    static constexpr bool PERM = true;
    bf16_t* GS;
    __device__ __forceinline__ void operator()(const f32x4 (&acc)[2][2][4][2], const Unit& u, int wr, int wc, int fr, int fq) const {
        const int g = u.pn; const int rg0 = (u.pm & 7) * BM + wr * 64 + fr;
        bf16_t* base = GS + ((size_t)(rg0 * 16 + wc * 2 + (fq >> 1)) * 1024 + g * 16 + (fq & 1) * 8);
#pragma unroll
        for (int ai = 0; ai < 2; ++ai)
#pragma unroll
            for (int m = 0; m < 4; ++m) {
#pragma unroll
                for (int bj = 0; bj < 2; ++bj) {
                    f32x4 v0 = acc[ai][bj][m][0], v1 = acc[ai][bj][m][1];
#pragma unroll
                    for (int j = 0; j < 4; ++j) { v0[j] = gelu_tanh(v0[j]); v1[j] = gelu_tanh(v1[j]); }
                    *(u32x4*)(base + (size_t)(ai * HALF + m * 16) * 16384 + bj * 8192) = pack8(v0, v1); }
                asm volatile("" ::: "memory"); }
    }
};
struct EpiYG {
    static constexpr bool PERM = true;
    const bf16_t* SZG; bf16_t* YG;
    __device__ __forceinline__ void operator()(const f32x4 (&acc)[2][2][4][2], const Unit& u, int wr, int wc, int fr, int fq) const {
        const int row0 = u.pm * BM + wr * 64 + fr, col0 = u.pn * BM + wc * 32 + 8 * fq;
#pragma unroll
        for (int ai = 0; ai < 2; ++ai)
#pragma unroll
            for (int m = 0; m < 4; ++m)
#pragma unroll
                for (int bj = 0; bj < 2; ++bj) { const size_t off = (size_t)(row0 + ai * HALF + m * 16) * 1024 + col0 + bj * HALF;
                    const u32x4 z = *(const u32x4*)(SZG + off); f32x4 v0 = acc[ai][bj][m][0], v1 = acc[ai][bj][m][1];
                    v0[0] *= bflo(z.x); v0[1] *= bfhi(z.x); v0[2] *= bflo(z.y); v0[3] *= bfhi(z.y); v1[0] *= bflo(z.z); v1[1] *= bfhi(z.z); v1[2] *= bflo(z.w); v1[3] *= bfhi(z.w);
                    *(u32x4*)(YG + off) = pack8(v0, v1); }
    }
};
struct EpiGlu {
    static constexpr bool PERM = true;
    const bf16_t *YG, *SZS; bf16_t* MIX; const float* b_glu;
    __device__ __forceinline__ void operator()(const f32x4 (&acc)[2][2][4][2], const Unit& u, int wr, int wc, int fr, int fq) const {
        const int row0 = u.pm * BM + wr * 64 + fr, c = u.pn * HALF + wc * 32 + 8 * fq;
        const f32x4 bv0 = *(const f32x4*)(b_glu + c), bv1 = *(const f32x4*)(b_glu + c + 4), bg0 = *(const f32x4*)(b_glu + 1024 + c), bg1 = *(const f32x4*)(b_glu + 1024 + c + 4);
#pragma unroll
        for (int ai = 0; ai < 2; ++ai)
#pragma unroll
            for (int m = 0; m < 4; ++m) { const size_t off = (size_t)(row0 + ai * HALF + m * 16) * 1024 + c;
                const u32x4 y = *(const u32x4*)(YG + off), z = *(const u32x4*)(SZS + off);
                f32x4 v0 = acc[ai][0][m][0] + bv0, v1 = acc[ai][0][m][1] + bv1, g0 = acc[ai][1][m][0] + bg0, g1 = acc[ai][1][m][1] + bg1;
#pragma unroll
                for (int j = 0; j < 4; ++j) { v0[j] *= sigmoidf_(g0[j]); v1[j] *= sigmoidf_(g1[j]); }
                v0[0] = bflo(y.x) + bflo(z.x) * v0[0]; v0[1] = bfhi(y.x) + bfhi(z.x) * v0[1]; v0[2] = bflo(y.y) + bflo(z.y) * v0[2]; v0[3] = bfhi(y.y) + bfhi(z.y) * v0[3];
                v1[0] = bflo(y.z) + bflo(z.z) * v1[0]; v1[1] = bfhi(y.z) + bfhi(z.z) * v1[1]; v1[2] = bflo(y.w) + bflo(z.w) * v1[2]; v1[3] = bfhi(y.w) + bfhi(z.w) * v1[3];
                *(u32x4*)(MIX + off) = pack8(v0, v1); }
    }
};
struct EpiRelu2 {
    static constexpr bool PERM = true;
    bf16_t* O; int ldc;
    __device__ __forceinline__ void operator()(const f32x4 (&acc)[2][2][4][2], const Unit& u, int wr, int wc, int fr, int fq) const {
        const int row0 = u.pm * BM + wr * 64 + fr, col0 = u.pn * BM + wc * 32 + 8 * fq;
#pragma unroll
        for (int ai = 0; ai < 2; ++ai)
#pragma unroll
            for (int m = 0; m < 4; ++m)
#pragma unroll
                for (int bj = 0; bj < 2; ++bj) { f32x4 v0 = acc[ai][bj][m][0], v1 = acc[ai][bj][m][1];
#pragma unroll
                    for (int j = 0; j < 4; ++j) { const float a = fmaxf(v0[j], 0.f), b = fmaxf(v1[j], 0.f); v0[j] = a * a; v1[j] = b * b; }
                    *(u32x4*)(O + (size_t)(row0 + ai * HALF + m * 16) * ldc + col0 + bj * HALF) = pack8(v0, v1); }
    }
};

template <class Epi, class Sched, bool ALIGN_EPI>
__device__ __forceinline__ void gemm_phase(PG8_LAS unsigned char* lds, const Gemm g, const Sched& S, const Epi& E, const int wid  ) {
    int lane_ = (int)__builtin_amdgcn_mbcnt_hi(~0u, __builtin_amdgcn_mbcnt_lo(~0u, 0u)); asm volatile("" : "+v"(lane_));
    const int lane = lane_, tid = wid * 64 + lane, wr = wid >> 2, wc = wid & 3, fr = lane & 15, fq = lane >> 4;
    const int nt = g.K / BK;
    unsigned voffA[2], voffB[2];
#pragma unroll
    for (int i = 0; i < 2; ++i) { int R, C; stage_rc(tid * 16 + i * 8192, R, C); const int Rb = Epi::PERM ? ((R & ~31) + perm32(R & 31)) : R;
        voffA[i] = (unsigned)(R * g.lda + C) * 2u; voffB[i] = (unsigned)(Rb * g.ldb + C) * 2u; }
    const size_t kstep = (size_t)(BK * 2);
    const size_t hstepA = (size_t)HALF * g.lda * 2, hstepB = (size_t)HALF * g.ldb * 2;
    const size_t tstepA = 2 * hstepA, tstepB = (size_t)g.tstepB_rows * g.ldb * 2;
    const unsigned ldsw = (unsigned)wid * 1024u;
    const int aoff = lds_byte(wr * 64 + fr, fq * 8), boff = lds_byte(wc * 32 + fr, fq * 8);
#define PG8_SA(b, h) (((b) * 2 + (h)) * HTB)
#define PG8_SB(b, h) ((4 + (b) * 2 + (h)) * HTB)
#define PG8_STAGE(bufoff, gbase, voff) do { _Pragma("unroll") for (int _i = 0; _i < 2; ++_i) \
        __builtin_amdgcn_global_load_lds((const unsigned*)((const char*)(gbase) + (voff)[_i]), (PG8_LAS unsigned*)(lds + (bufoff) + ldsw + _i * 8192), 16, 0, 0); } while (0)
#define PG8_LDA(dst, b, h) do { _Pragma("unroll") for (int m = 0; m < 4; ++m) _Pragma("unroll") for (int k = 0; k < 2; ++k) dst[m][k] = *(const PG8_LAS bf16x8*)(lds + PG8_SA(b, h) + aoff + m * 2048 + k * 1024); } while (0)
#define PG8_LDB(dst, b, h) do { _Pragma("unroll") for (int n = 0; n < 2; ++n) _Pragma("unroll") for (int k = 0; k < 2; ++k) dst[n][k] = *(const PG8_LAS bf16x8*)(lds + PG8_SB(b, h) + boff + n * 2048 + k * 1024); } while (0)
#define PG8_MMA(ai, bj, At, Bt) do { __builtin_amdgcn_s_setprio(1); _Pragma("unroll") for (int m = 0; m < 4; ++m) _Pragma("unroll") for (int n = 0; n < 2; ++n) _Pragma("unroll") for (int k = 0; k < 2; ++k) \
        acc[ai][bj][m][n] = __builtin_amdgcn_mfma_f32_16x16x32_bf16(Bt[n][k], At[m][k], acc[ai][bj][m][n], 0, 0, 0); __builtin_amdgcn_s_setprio(0); } while (0)
#define PG8_WAIT_V(n) asm volatile("s_waitcnt vmcnt(" #n ")" ::: "memory")
#define PG8_WAIT_L(n) asm volatile("s_waitcnt lgkmcnt(" #n ")" ::: "memory")
#define PG8_BAR __builtin_amdgcn_s_barrier()
#define PG8_SCHED __builtin_amdgcn_sched_barrier(0)
    Unit cur, nxt; int ui = 0;
    if (!S.next(0, cur)) return;
    f32x4 acc[2][2][4][2];
#pragma unroll
    for (int a = 0; a < 2; ++a)
#pragma unroll
        for (int b = 0; b < 2; ++b)
#pragma unroll
            for (int m = 0; m < 4; ++m)
#pragma unroll
                for (int n = 0; n < 2; ++n) acc[a][b][m][n] = (f32x4){0.f, 0.f, 0.f, 0.f};
    bf16x8 At[4][2], B0[2][2], B1[2][2];
    const char* cA = (const char*)g.A + (size_t)cur.pm * tstepA; const char* cB = (const char*)g.Bt + (size_t)cur.pn * tstepB;
    PG8_STAGE(PG8_SB(0, 0), cB, voffB); PG8_STAGE(PG8_SB(0, 1), cB + hstepB, voffB); PG8_STAGE(PG8_SA(0, 0), cA, voffA); PG8_STAGE(PG8_SA(0, 1), cA + hstepA, voffA);
    if (wr == 1) PG8_BAR;
    PG8_WAIT_V(2); PG8_BAR;
    PG8_STAGE(PG8_SB(1, 0), cB + kstep, voffB); PG8_STAGE(PG8_SA(1, 0), cA + kstep, voffA); PG8_STAGE(PG8_SB(1, 1), cB + hstepB + kstep, voffB);
    PG8_WAIT_V(6); PG8_BAR;
    for (;;) {
        const bool has_next = S.next(ui + 1, nxt);
        const char* nA = has_next ? (const char*)g.A + (size_t)nxt.pm * tstepA : cA; const char* nB = has_next ? (const char*)g.Bt + (size_t)nxt.pn * tstepB : cB;
        for (int t = 0; t < nt; t += 2) {
            const bool last = (t == nt - 2);
            const char* a1 = cA + (size_t)(t + 1) * kstep;
            const char* a2 = last ? nA : cA + (size_t)(t + 2) * kstep; const char* b2 = last ? nB : cB + (size_t)(t + 2) * kstep;
            const char* a3 = a2 + kstep; const char* b3 = b2 + kstep;
            PG8_LDB(B0, 0, 0); PG8_LDB(B1, 0, 1); PG8_SCHED; PG8_LDA(At, 0, 0); PG8_STAGE(PG8_SA(1, 1), a1 + hstepA, voffA);
            PG8_WAIT_V(8); PG8_WAIT_L(0); PG8_BAR; PG8_MMA(0, 0, At, B0); PG8_MMA(0, 1, At, B1); PG8_BAR; PG8_SCHED;
            PG8_LDA(At, 0, 1); PG8_STAGE(PG8_SB(0, 0), b2, voffB); PG8_STAGE(PG8_SB(0, 1), b2 + hstepB, voffB); PG8_STAGE(PG8_SA(0, 0), a2, voffA);
            PG8_WAIT_V(8); PG8_WAIT_L(0); PG8_BAR; PG8_MMA(1, 0, At, B0); PG8_MMA(1, 1, At, B1); PG8_BAR; PG8_SCHED;
            PG8_LDB(B0, 1, 0); PG8_LDB(B1, 1, 1); PG8_SCHED; PG8_LDA(At, 1, 0); PG8_STAGE(PG8_SA(0, 1), a2 + hstepA, voffA);
            PG8_WAIT_V(8); PG8_WAIT_L(0); PG8_BAR; PG8_MMA(0, 0, At, B0); PG8_MMA(0, 1, At, B1); PG8_BAR; PG8_SCHED;
            PG8_LDA(At, 1, 1); PG8_STAGE(PG8_SB(1, 0), b3, voffB); PG8_STAGE(PG8_SB(1, 1), b3 + hstepB, voffB); PG8_STAGE(PG8_SA(1, 0), a3, voffA);
            PG8_WAIT_V(8); PG8_WAIT_L(0); PG8_BAR; PG8_MMA(1, 0, At, B0); PG8_MMA(1, 1, At, B1); PG8_BAR; PG8_SCHED;
        }
        if constexpr (ALIGN_EPI) { if (wr == 0) PG8_BAR; }
        { int le = (int)__builtin_amdgcn_mbcnt_hi(~0u, __builtin_amdgcn_mbcnt_lo(~0u, 0u)); asm volatile("" : "+v"(le)); E(acc, cur, wr, wc, le & 15, le >> 4); }
        if (!has_next) break;
#pragma unroll
        for (int a = 0; a < 2; ++a)
#pragma unroll
            for (int b = 0; b < 2; ++b)
#pragma unroll
                for (int m = 0; m < 4; ++m)
#pragma unroll
                    for (int n = 0; n < 2; ++n) acc[a][b][m][n] = (f32x4){0.f, 0.f, 0.f, 0.f};
        cur = nxt; cA = nA; cB = nB; ++ui;
        if constexpr (ALIGN_EPI) { if (wr == 1) PG8_BAR; }
    }
    PG8_WAIT_V(0);
    if constexpr (!ALIGN_EPI) { if (wr == 0) PG8_BAR; }
    PG8_BAR;
#undef PG8_SA
#undef PG8_SB
#undef PG8_STAGE
#undef PG8_LDA
#undef PG8_LDB
#undef PG8_MMA
#undef PG8_WAIT_V
#undef PG8_WAIT_L
#undef PG8_BAR
#undef PG8_SCHED
}
}

constexpr int NWAVES = 8;
constexpr int BATCH = 8, SEQ = 4096, D = 1024, M = BATCH * SEQ, NMETA = 16;
constexpr int NH = 4, DKH = 128, DVH = 256, GKEY = 512, GVAL = 1024, RANK = 16;
constexpr int SG = 64, SHG = 16, SN = 64, FF = 4096, IN_W = 6160, NIN = 6656;
constexpr int SRC_A = 3072, SRC_U = 3088;
constexpr float EPS = 1e-6f;
constexpr int N_LAUNCHES = MK_N_LAUNCHES;
constexpr int N_PHASES = 11;

constexpr size_t MiB = 1u << 20;
constexpr size_t WS_CTL = 0, CTL_ZERO_BYTES = 1 * MiB;
constexpr size_t WS_SMALL = 1 * MiB;
constexpr size_t WS_WIN = 2 * MiB, WS_WO = 15 * MiB, WS_WGLU = 17 * MiB, WS_WOUT = 21 * MiB, WS_WFF1 = 23 * MiB, WS_WFF2 = 31 * MiB;
constexpr size_t WS_TZ = 39 * MiB;
constexpr size_t WS_MS = 51 * MiB;
constexpr size_t WS_XN = 56 * MiB;
constexpr size_t WS_Q = 120 * MiB, WS_K = 152 * MiB, WS_V = 184 * MiB, WS_SR = 248 * MiB, WS_LA = 312 * MiB, WS_UH = 344 * MiB;
constexpr size_t WS_GS = 120 * MiB;
constexpr size_t WS_YG = 184 * MiB;
constexpr size_t WS_MIX = 248 * MiB;
constexpr size_t WS_T = 312 * MiB;
constexpr size_t WS_F1 = 120 * MiB;
constexpr size_t WS_T2 = 376 * MiB;
constexpr size_t WS_DS = 440 * MiB;
constexpr size_t WS_END = 504 * MiB;
constexpr size_t SM_KM = 0;
constexpr size_t SM_VM = SM_KM + 16 * 512 * 4;
constexpr size_t SM_AL = SM_VM + 16 * 1024 * 4;
constexpr size_t SM_UM = SM_AL + 16 * 16 * 4;
constexpr size_t SM_L16 = SM_UM + 16 * 1024 * 4;
constexpr size_t SM_HM = SM_L16 + 64 * 64 * 2 * 4;
constexpr size_t SM_END = SM_HM + 64 * 128 * 4;
static_assert(SM_END <= MiB, "small region");
constexpr int CW_BAR = 4096;

constexpr int RING_BYTES = 139264;
constexpr int LDSCTL_OFF = RING_BYTES, MISC_OFF = LDSCTL_OFF + 320;
constexpr int LDS_BYTES = 147456;

#define GAS __attribute__((address_space(1)))
#define LAS __attribute__((address_space(3)))
typedef unsigned short bf16;
typedef unsigned v4u __attribute__((ext_vector_type(4)));
typedef unsigned v2u __attribute__((ext_vector_type(2)));
typedef float f32x4 __attribute__((ext_vector_type(4)));
typedef float f32x16 __attribute__((ext_vector_type(16)));
typedef short bf16x8 __attribute__((ext_vector_type(8)));
#define LDS_WAIT() asm volatile("s_waitcnt lgkmcnt(0)" ::: "memory")
#define VM_WAIT() asm volatile("s_waitcnt vmcnt(0)" ::: "memory")
__device__ __forceinline__ unsigned f2bf(float f) { unsigned u = __builtin_bit_cast(unsigned, f); return (u + 0x7fffu + ((u >> 16) & 1u)) >> 16; }
__device__ __forceinline__ unsigned pk2(float lo, float hi) { return f2bf(lo) | (f2bf(hi) << 16); }
__device__ __forceinline__ float bf2f(bf16 b) { return __uint_as_float((unsigned)b << 16); }

#define XB_TMO      128
#define XB_XCNT(j)  (256  + 64 * (j))
#define XB_XSUB(j)  (1280 + 64 * (j))
#define XB_XGEN(j)  (2304 + 64 * (j))
#define XB_TOP      3328
#define XB_TOPGEN   3392
#define XCD_BAR_WORDS 3456
#define XB_SPIN_CAP (1u << 18)
__device__ __forceinline__ unsigned xb_ld(unsigned* p)              { return __hip_atomic_load(p, __ATOMIC_RELAXED, __HIP_MEMORY_SCOPE_AGENT); }
__device__ __forceinline__ unsigned xb_add(unsigned* p, unsigned v) { return __hip_atomic_fetch_add(p, v, __ATOMIC_RELAXED, __HIP_MEMORY_SCOPE_AGENT); }
__device__ __forceinline__ unsigned xb_xcc_id() { return (unsigned)__builtin_amdgcn_s_getreg((3 << 11) | 20) & 0xFu; }
#define XB_SPIN(cond, bar) do { unsigned _sp = 0; while (cond) { __builtin_amdgcn_s_sleep(1); \
    if ((++_sp & 255u) == 0u) { if (xb_ld(&(bar)[XB_TMO])) break; if (_sp > XB_SPIN_CAP) { atomicAdd(&(bar)[XB_TMO], 1u); break; } } } } while (0)
struct XcdBarrier { unsigned* bar; unsigned x; volatile LAS unsigned* st; };
__device__ __forceinline__ XcdBarrier xcd_barrier_post(unsigned* bar, volatile LAS unsigned* st, bool t0) {
    XcdBarrier b; b.bar = bar; b.x = xb_xcc_id(); b.st = st;
    if (t0) (void)xb_add(&bar[XB_XCNT(b.x)], 1u);
    return b;
}
__device__ __forceinline__ void xcd_barrier_complete(unsigned* bar, unsigned x, unsigned& nloc, unsigned& nx) {
    const unsigned G = gridDim.x * gridDim.y * gridDim.z;
    unsigned sum, cnt, mine, sp = 0u;
    for (;;) {
        sum = 0u; cnt = 0u; mine = 0u;
#pragma unroll
        for (unsigned j = 0; j < 16; ++j) { const unsigned c = xb_ld(&bar[XB_XCNT(j)]); sum += c; cnt += (c > 0u) ? 1u : 0u; mine = (j == x) ? c : mine; }
        if (sum == G) break;
        __builtin_amdgcn_s_sleep(1);
        if ((++sp & 255u) == 0u) { if (xb_ld(&bar[XB_TMO])) break; if (sp > XB_SPIN_CAP) { atomicAdd(&bar[XB_TMO], 1u); break; } }
    }
    nloc = mine > 0u ? mine : 1u; nx = cnt > 0u ? cnt : 1u;
}
__device__ __forceinline__ void xcd_barrier(const XcdBarrier& b, bool t0) {
    asm volatile("s_waitcnt vmcnt(0)" ::: "memory");
    __syncthreads();
    if (t0) {
        unsigned* bar = b.bar;
        __builtin_amdgcn_s_waitcnt(0);
        unsigned nloc = b.st[0], nx = b.st[1];
        if (nloc == 0u) { xcd_barrier_complete(bar, b.x, nloc, nx); b.st[0] = nloc; b.st[1] = nx; }
        const unsigned old = xb_add(&bar[XB_XSUB(b.x)], 1u);
        const unsigned gen = old / nloc;
        if (old + 1u == (gen + 1u) * nloc) {
            __builtin_amdgcn_fence(__ATOMIC_RELEASE, "agent");
            asm volatile("s_waitcnt vmcnt(0)" ::: "memory");
            const unsigned og = xb_add(&bar[XB_TOP], 1u);
            const unsigned tg = og / nx;
            if (og + 1u == (tg + 1u) * nx) xb_add(&bar[XB_TOPGEN], 1u);
            else XB_SPIN(xb_ld(&bar[XB_TOPGEN]) == tg, bar);
            __builtin_amdgcn_fence(__ATOMIC_ACQUIRE, "agent");
            xb_add(&bar[XB_XGEN(b.x)], 1u);
            asm volatile("s_waitcnt vmcnt(0)" ::: "memory");
        } else {
            XB_SPIN(xb_ld(&bar[XB_XGEN(b.x)]) == gen, bar);
            __builtin_amdgcn_fence(__ATOMIC_ACQUIRE, "agent");
            asm volatile("s_waitcnt vmcnt(0)" ::: "memory");
        }
    }
    __syncthreads();
}

struct Args { const float* in[24]; float* out; unsigned char* ws; int ph_lo, ph_hi, li, pad; };

__device__ __forceinline__ int launder_idx(int i) { asm volatile("" : "+s"(i)); return i; }
__device__ __forceinline__ float wave_sum(float v) {
#pragma unroll
    for (int o = 1; o < 64; o <<= 1) v += __shfl_xor(v, o);
    return v;
}

__device__ __forceinline__ void p0_transpose_item(const float* W, int ldw, int src_col0, int K, bf16* WT, int dst_row0, LAS float* scr, int kb, int lane) {
    const int k0 = 64 * kb;
#pragma unroll 16
    for (int i = 0; i < 32; ++i) { const int kk = 2 * i + (lane >> 5); scr[kk * 33 + (lane & 31)] = W[(size_t)(k0 + kk) * ldw + src_col0 + (lane & 31)]; }
    LDS_WAIT(); asm volatile("" ::: "memory");
    const int c = lane & 7;
#pragma unroll
    for (int j = 0; j < 4; ++j) { const int n = (lane >> 3) + 8 * j; const LAS float* s = scr + (8 * c) * 33 + n;
        v4u o; o.x = pk2(s[0 * 33], s[1 * 33]); o.y = pk2(s[2 * 33], s[3 * 33]); o.z = pk2(s[4 * 33], s[5 * 33]); o.w = pk2(s[6 * 33], s[7 * 33]);
        *(GAS v4u*)(WT + (size_t)(dst_row0 + n) * K + k0 + 8 * c) = o; }
    LDS_WAIT(); asm volatile("" ::: "memory");
}
__device__ __forceinline__ void rms_row_to_bf16(const float* xrow, const float* gain, bf16* orow, int lane) {
    const GAS f32x4* xr = (const GAS f32x4*)xrow + lane; const GAS f32x4* gr = (const GAS f32x4*)gain + lane;
    f32x4 v[4]; float s = 0.f;
#pragma unroll
    for (int j = 0; j < 4; ++j) { v[j] = xr[64 * j]; s += (v[j].x * v[j].x + v[j].y * v[j].y) + (v[j].z * v[j].z + v[j].w * v[j].w); }
    const float rs = 1.0f / sqrtf(wave_sum(s) * (1.f / 1024.f) + EPS);
    GAS unsigned long long* o8 = (GAS unsigned long long*)orow + lane;
#pragma unroll
    for (int j = 0; j < 4; ++j) { const f32x4 g = gr[64 * j];
        o8[64 * j] = (unsigned long long)pk2(v[j].x * rs * g.x, v[j].y * rs * g.y) | ((unsigned long long)pk2(v[j].z * rs * g.z, v[j].w * rs * g.w) << 32); }
}
struct cpx { float r, i; };
__device__ __forceinline__ cpx cmul(cpx a, cpx b) { return cpx{a.r * b.r - a.i * b.i, a.r * b.i + a.i * b.r}; }

namespace gla {
typedef short s16x4 __attribute__((ext_vector_type(4)));
typedef short v4i16_t __attribute__((ext_vector_type(4)));
constexpr int QP = 136, XP = 160, VP = 288, PP = 72, OP = 264;
constexpr int O_QE = 0, O_B = 17408, O_KI = O_B + 33792, O_KX = O_KI + 17408, O_V = O_KX + 64 * XP * 2, O_P = O_V + 64 * VP * 2, O_DK = O_P + 64 * PP * 2, O_TOT = O_DK + 512, O_END = O_TOT + 2048;
static_assert(O_END <= RING_BYTES, "gla lds");
__device__ __forceinline__ s16x4 tr4(const LAS unsigned char* p) { return __builtin_bit_cast(s16x4, __builtin_amdgcn_ds_read_tr16_b64_v4i16((LAS v4i16_t*)p)); }
__device__ __forceinline__ bf16x8 cat8(s16x4 a, s16x4 b) { return __builtin_shufflevector(a, b, 0, 1, 2, 3, 4, 5, 6, 7); }

struct Pref { unsigned la[16]; v4u k[2], q[2], v[4]; };
__device__ __forceinline__ void prefetch_la(Pref& pf, const bf16* __restrict__ LAg, int m0, int h, int tid) {
    const bf16* lp = LAg + (size_t)(m0 + 16 * (tid >> 7)) * GKEY + h * DKH + (tid & 127);
#pragma unroll
    for (int i = 0; i < 16; ++i) pf.la[i] = (unsigned)lp[(size_t)i * GKEY];
}
__device__ __forceinline__ void prefetch_v(Pref& pf, const bf16* __restrict__ Vg, int m0, int h, int tid) {
#pragma unroll
    for (int j = 0; j < 4; ++j) pf.v[j] = *(const GAS v4u*)(Vg + (size_t)(m0 + (tid >> 5) + 16 * j) * GVAL + h * DVH + (tid & 31) * 8);
}
template <bool WANT_O>
__device__ __forceinline__ void prefetch_kq(Pref& pf, const bf16* __restrict__ Qg, const bf16* __restrict__ Kg, int m0, int h, int tid) {
#pragma unroll
    for (int i = 0; i < 2; ++i) { const size_t o = (size_t)(m0 + (tid >> 4) + 32 * i) * GKEY + h * DKH + (tid & 15) * 8;
        pf.k[i] = *(const GAS v4u*)(Kg + o); if (WANT_O) pf.q[i] = *(const GAS v4u*)(Qg + o); }
}
template <bool WANT_O>
__device__ __forceinline__ void prefetch(Pref& pf, const bf16* __restrict__ Qg, const bf16* __restrict__ Kg, const bf16* __restrict__ LAg, const bf16* __restrict__ Vg, int m0, int h, int tid) {
    prefetch_la(pf, LAg, m0, h, tid); prefetch_v(pf, Vg, m0, h, tid); prefetch_kq<WANT_O>(pf, Qg, Kg, m0, h, tid);
}

template <bool WANT_O>
__device__ __forceinline__ void chunk(LAS unsigned char* lds, const bf16* __restrict__ Qg, const bf16* __restrict__ Kg, const bf16* __restrict__ LAg, const bf16* __restrict__ Vg,
                                      const bf16* __restrict__ SRg, const float* __restrict__ gn, bf16* __restrict__ OG, int m0, int m0n, int h, f32x16 (&S)[4], Pref& pf, float& dsum,
                                      int tid, int wid, int lane) {
    LAS bf16* QE = (LAS bf16*)(lds + O_QE); LAS float* Bm = (LAS float*)(lds + O_B); LAS bf16* OT = (LAS bf16*)(lds + O_B); LAS bf16* KI = (LAS bf16*)(lds + O_KI);
    LAS bf16* KX = (LAS bf16*)(lds + O_KX); LAS bf16* Vs = (LAS bf16*)(lds + O_V); LAS bf16* P = (LAS bf16*)(lds + O_P);
    LAS float* DKs = (LAS float*)(lds + O_DK); LAS float* TOT = (LAS float*)(lds + O_TOT);
    const int kc = tid & 127, tq = tid >> 7;
    float c16[16];
    { float run = 0.f;
#pragma unroll
      for (int i = 0; i < 16; ++i) { run += pg8::bflo(pf.la[i]); c16[i] = run; }
      TOT[tq * 128 + kc] = run; }
    if (m0n >= 0) prefetch_la(pf, LAg, m0n, h, tid);
    LDS_WAIT(); __builtin_amdgcn_s_barrier(); asm volatile("" ::: "memory");
    { const float t0 = TOT[kc], t1 = TOT[128 + kc], t2 = TOT[256 + kc], t3 = TOT[384 + kc];
      const float off = tq == 0 ? 0.f : (tq == 1 ? t0 : (tq == 2 ? t0 + t1 : t0 + t1 + t2));
      if (tq == 0) dsum += (t0 + t1) + (t2 + t3);
#pragma unroll
      for (int i = 0; i < 16; ++i) Bm[(16 * tq + i) * 128 + kc] = off + c16[i]; }
#pragma unroll
    for (int j = 0; j < 4; ++j) *(LAS v4u*)(Vs + ((tid >> 5) + 16 * j) * VP + (tid & 31) * 8) = pf.v[j];
    if (m0n >= 0) prefetch_v(pf, Vg, m0n, h, tid);
    LDS_WAIT(); __builtin_amdgcn_s_barrier(); asm volatile("" ::: "memory");
    { const int kblk = (tid & 15) * 8, b16 = kblk & ~15, p0 = b16 + ((kblk & 8) ? 4 : 0), p1 = b16 + ((kblk & 8) ? 12 : 8);
#pragma unroll
      for (int i = 0; i < 2; ++i) { const int t = (tid >> 4) + 32 * i;
        const f32x4 b0 = *(const LAS f32x4*)(Bm + t * 128 + kblk), b1 = *(const LAS f32x4*)(Bm + t * 128 + kblk + 4);
        float e[8], r[8];
#pragma unroll
        for (int j = 0; j < 4; ++j) { e[j] = __expf(b0[j]); e[4 + j] = __expf(b1[j]); }
#pragma unroll
        for (int j = 0; j < 8; ++j) r[j] = __builtin_amdgcn_rcpf(e[j]);
        const v4u kw = pf.k[i];
        const float k0 = pg8::bflo(kw.x) * r[0], k1 = pg8::bfhi(kw.x) * r[1], k2 = pg8::bflo(kw.y) * r[2], k3 = pg8::bfhi(kw.y) * r[3];
        const float k4 = pg8::bflo(kw.z) * r[4], k5 = pg8::bfhi(kw.z) * r[5], k6 = pg8::bflo(kw.w) * r[6], k7 = pg8::bfhi(kw.w) * r[7];
        const unsigned w0 = pk2(k0, k1), w1 = pk2(k2, k3), w2 = pk2(k4, k5), w3 = pk2(k6, k7);
        *(LAS v4u*)(KX + t * XP + kblk) = (v4u){w0, w1, w2, w3};
        if (WANT_O) {
            *(LAS v2u*)(KI + t * QP + p0) = (v2u){w0, w1}; *(LAS v2u*)(KI + t * QP + p1) = (v2u){w2, w3};
            const v4u qw = pf.q[i];
            const unsigned q0 = pk2(pg8::bflo(qw.x) * e[0], pg8::bfhi(qw.x) * e[1]), q1 = pk2(pg8::bflo(qw.y) * e[2], pg8::bfhi(qw.y) * e[3]);
            const unsigned q2 = pk2(pg8::bflo(qw.z) * e[4], pg8::bfhi(qw.z) * e[5]), q3 = pk2(pg8::bflo(qw.w) * e[6], pg8::bfhi(qw.w) * e[7]);
            *(LAS v2u*)(QE + t * QP + p0) = (v2u){q0, q1}; *(LAS v2u*)(QE + t * QP + p1) = (v2u){q2, q3};
        } }
      if (tid < 16) { const f32x4 l0 = *(const LAS f32x4*)(Bm + 63 * 128 + 8 * tid), l1 = *(const LAS f32x4*)(Bm + 63 * 128 + 8 * tid + 4);
        *(LAS f32x4*)(DKs + 8 * tid) = (f32x4){__expf(l0[0]), __expf(l0[1]), __expf(l0[2]), __expf(l0[3])};
        *(LAS f32x4*)(DKs + 8 * tid + 4) = (f32x4){__expf(l1[0]), __expf(l1[1]), __expf(l1[2]), __expf(l1[3])}; } }
    if (m0n >= 0) prefetch_kq<WANT_O>(pf, Qg, Kg, m0n, h, tid);
    LDS_WAIT(); __builtin_amdgcn_s_barrier(); asm volatile("" ::: "memory");
    const int fr = lane & 15, fq = lane >> 4, r = lane & 31, hh = lane >> 5, v0 = 32 * wid;
    const int trq = (lane & 15) >> 2, trp = lane & 3, blk = (lane >> 4) & 1;
    v4u sw[4];
    const size_t gbase = (size_t)(m0 + (tid >> 3)) * GVAL + h * DVH + (tid & 7) * 8;
    if (WANT_O) {
#pragma unroll
        for (int j = 0; j < 4; ++j) sw[j] = *(const GAS v4u*)(SRg + gbase + 64 * j);
    }
    if (WANT_O) {
#pragma unroll
        for (int rep = 0; rep < 2; ++rep) {
            const int idx = wid + 8 * rep;
            if (idx < 10) {
                const int ti = idx >= 6 ? 3 : (idx >= 3 ? 2 : (idx >= 1 ? 1 : 0)), si = idx - (ti * (ti + 1)) / 2;
                pg8::f32x4 acc = (pg8::f32x4){0.f, 0.f, 0.f, 0.f};
#pragma unroll
                for (int ks = 0; ks < 4; ++ks) {
                    const bf16x8 a = *(const LAS bf16x8*)(QE + (16 * ti + fr) * QP + 32 * ks + 8 * fq);
                    const bf16x8 b = *(const LAS bf16x8*)(KI + (16 * si + fr) * QP + 32 * ks + 8 * fq);
                    acc = __builtin_amdgcn_mfma_f32_16x16x32_bf16(a, b, acc, 0, 0, 0);
                }
                const int s = 16 * si + fr;
#pragma unroll
                for (int rg = 0; rg < 4; ++rg) { const int t = 16 * ti + 4 * fq + rg; P[t * PP + s] = (bf16)f2bf(s <= t ? acc[rg] : 0.f); }
            }
        }
        LDS_WAIT(); __builtin_amdgcn_s_barrier(); asm volatile("" ::: "memory");
    }
    bf16x8 vf[4];
    { const LAS unsigned char* vb = (const LAS unsigned char*)Vs + (8 * hh + trq) * (VP * 2) + (v0 + 16 * blk + 4 * trp) * 2;
#pragma unroll
      for (int ks = 0; ks < 4; ++ks) vf[ks] = cat8(tr4(vb + (16 * ks) * (VP * 2)), tr4(vb + (16 * ks + 4) * (VP * 2))); }
    f32x16 o[2];
    if (WANT_O) {
#pragma unroll
        for (int tt = 0; tt < 2; ++tt) {
#pragma unroll
            for (int j = 0; j < 16; ++j) o[tt][j] = 0.f;
#pragma unroll
            for (int ks = 0; ks < 4; ++ks) if (tt == 1 || ks < 2) {
                const bf16x8 a = *(const LAS bf16x8*)(P + (32 * tt + r) * PP + 16 * ks + 8 * hh);
                o[tt] = __builtin_amdgcn_mfma_f32_32x32x16_bf16(a, vf[ks], o[tt], 0, 0, 0);
            }
        }
#pragma unroll
        for (int kt = 0; kt < 4; ++kt)
#pragma unroll
            for (int s2 = 0; s2 < 2; ++s2) {
                v4u bw; bw.x = pk2(S[kt][8 * s2 + 0], S[kt][8 * s2 + 1]); bw.y = pk2(S[kt][8 * s2 + 2], S[kt][8 * s2 + 3]);
                bw.z = pk2(S[kt][8 * s2 + 4], S[kt][8 * s2 + 5]); bw.w = pk2(S[kt][8 * s2 + 6], S[kt][8 * s2 + 7]);
                const bf16x8 bfr = __builtin_bit_cast(bf16x8, bw);
#pragma unroll
                for (int tt = 0; tt < 2; ++tt) {
                    const bf16x8 a = *(const LAS bf16x8*)(QE + (32 * tt + r) * QP + 32 * kt + 16 * s2 + 8 * hh);
                    o[tt] = __builtin_amdgcn_mfma_f32_32x32x16_bf16(a, bfr, o[tt], 0, 0, 0);
                }
            }
    }
    { const LAS unsigned char* kb = (const LAS unsigned char*)KX + (8 * hh + trq) * (XP * 2) + (16 * blk + 4 * trp) * 2;
#pragma unroll
      for (int kt = 0; kt < 4; ++kt) {
#pragma unroll
        for (int ks = 0; ks < 4; ++ks) {
            const bf16x8 a = cat8(tr4(kb + (16 * ks) * (XP * 2) + 64 * kt), tr4(kb + (16 * ks + 4) * (XP * 2) + 64 * kt));
            S[kt] = __builtin_amdgcn_mfma_f32_32x32x16_bf16(a, vf[ks], S[kt], 0, 0, 0);
        }
#pragma unroll
        for (int g4 = 0; g4 < 4; ++g4) { const f32x4 d4 = *(const LAS f32x4*)(DKs + 32 * kt + 8 * g4 + 4 * hh);
#pragma unroll
            for (int e = 0; e < 4; ++e) S[kt][4 * g4 + e] *= d4[e]; }
      } }
    if (WANT_O) {
#pragma unroll
        for (int tt = 0; tt < 2; ++tt)
#pragma unroll
            for (int j = 0; j < 16; ++j) OT[(32 * tt + (j & 3) + 8 * (j >> 2) + 4 * hh) * OP + v0 + r] = (bf16)f2bf(o[tt][j]);
        LDS_WAIT(); __builtin_amdgcn_s_barrier(); asm volatile("" ::: "memory");
        const int t = tid >> 3, part = tid & 7;
        v4u ow[4]; float q = 0.f;
#pragma unroll
        for (int j = 0; j < 4; ++j) ow[j] = *(const LAS v4u*)(OT + t * OP + part * 8 + 64 * j);
#pragma unroll
        for (int j = 0; j < 4; ++j) { const float a0 = pg8::bflo(ow[j].x), a1 = pg8::bfhi(ow[j].x), a2 = pg8::bflo(ow[j].y), a3 = pg8::bfhi(ow[j].y), a4 = pg8::bflo(ow[j].z), a5 = pg8::bfhi(ow[j].z), a6 = pg8::bflo(ow[j].w), a7 = pg8::bfhi(ow[j].w);
            q += (a0 * a0 + a1 * a1) + (a2 * a2 + a3 * a3) + (a4 * a4 + a5 * a5) + (a6 * a6 + a7 * a7); }
        q += __shfl_xor(q, 1); q += __shfl_xor(q, 2); q += __shfl_xor(q, 4);
        const float rs = 1.0f / sqrtf(q * (1.f / 256.f) + EPS);
#pragma unroll
        for (int j = 0; j < 4; ++j) { const f32x4 g0 = *(const GAS f32x4*)(gn + h * DVH + part * 8 + 64 * j), g1 = *(const GAS f32x4*)(gn + h * DVH + part * 8 + 64 * j + 4);
            v4u w;
            w.x = pk2(pg8::bflo(ow[j].x) * rs * g0[0] * pg8::bflo(sw[j].x), pg8::bfhi(ow[j].x) * rs * g0[1] * pg8::bfhi(sw[j].x));
            w.y = pk2(pg8::bflo(ow[j].y) * rs * g0[2] * pg8::bflo(sw[j].y), pg8::bfhi(ow[j].y) * rs * g0[3] * pg8::bfhi(sw[j].y));
            w.z = pk2(pg8::bflo(ow[j].z) * rs * g1[0] * pg8::bflo(sw[j].z), pg8::bfhi(ow[j].z) * rs * g1[1] * pg8::bfhi(sw[j].z));
            w.w = pk2(pg8::bflo(ow[j].w) * rs * g1[2] * pg8::bflo(sw[j].w), pg8::bfhi(ow[j].w) * rs * g1[3] * pg8::bfhi(sw[j].w));
            *(GAS v4u*)(OG + gbase + 64 * j) = w; }
    }
}

__device__ __forceinline__ void meta_state(LAS unsigned char* lds, const float* KM, const float* VM, const float* AL, const float* wgu, const float* bgate, int h, f32x16 (&S)[4], int tid, int wid, int lane) {
    LAS float* LM = (LAS float*)lds;
    LAS float* KS = (LAS float*)(lds + 8192);
    const int kc = tid & 127, part = tid >> 7;
#pragma unroll
    for (int i = 0; i < 4; ++i) { const int s = 4 * part + i; float z = bgate[h * DKH + kc];
#pragma unroll
        for (int rr = 0; rr < RANK; ++rr) z += AL[s * RANK + rr] * wgu[rr * GKEY + h * DKH + kc];
        LM[s * 128 + kc] = pg8::logsigf_(z) * 0.0625f; }
    LDS_WAIT(); __syncthreads();
    if (part == 0) { float suf = 0.f;
        for (int s = 15; s >= 0; --s) { KS[s * 128 + kc] = KM[s * GKEY + h * DKH + kc] * __expf(suf); suf += LM[s * 128 + kc]; } }
    LDS_WAIT(); __syncthreads();
    const int r = lane & 31, hh = lane >> 5, v0 = 32 * wid;
    float vm[16];
#pragma unroll
    for (int s = 0; s < 16; ++s) vm[s] = VM[s * GVAL + h * DVH + v0 + r];
#pragma unroll
    for (int kt = 0; kt < 4; ++kt)
#pragma unroll
        for (int g4 = 0; g4 < 4; ++g4) { f32x4 a = (f32x4){0.f, 0.f, 0.f, 0.f};
#pragma unroll
            for (int s = 0; s < 16; ++s) a += *(const LAS f32x4*)(KS + s * 128 + 32 * kt + 8 * g4 + 4 * hh) * vm[s];
#pragma unroll
            for (int e = 0; e < 4; ++e) S[kt][4 * g4 + e] = a[e]; }
    LDS_WAIT(); __syncthreads();
}
}

__global__ void __launch_bounds__(NWAVES * 64, 2) fwd_kernel(Args args) {
    extern __shared__ __attribute__((aligned(16))) unsigned char lds_raw[];
    LAS unsigned char* lds = (LAS unsigned char*)lds_raw;
    volatile LAS unsigned* MISC = (volatile LAS unsigned*)(lds + MISC_OFF);
    const int G = gridDim.x; const int bx = blockIdx.x; const int vcu = (G % 8 == 0) ? (bx % 8) * (G / 8) + bx / 8 : bx;
    const int wave = __builtin_amdgcn_readfirstlane((int)threadIdx.x >> 6);
#define LANE_ID() ((int)__builtin_amdgcn_mbcnt_hi(~0u, __builtin_amdgcn_mbcnt_lo(~0u, 0u)))
#define T0() (wave == 0 && LANE_ID() == 0)
#define PHASE_IDS() int lane_ = LANE_ID(); asm volatile("" : "+v"(lane_)); const int lane = lane_, tid = wave * 64 + lane; const int gw = vcu * NWAVES + wave, NGW = G * NWAVES; (void)tid; (void)gw; (void)NGW
    unsigned char* ws = args.ws;
    unsigned* ctl = (unsigned*)(ws + WS_CTL);
#define INP(i) (args.in[launder_idx(i)])
#define x_in INP(0)
#define meta_tokens INP(1)
#define g_mix_pre INP(2)
#define w_in INP(3)
#define w_gate_up INP(4)
#define b_gate INP(5)
#define gla_norm_g INP(6)
#define w_o_gla INP(7)
#define a_re INP(8)
#define a_im INP(9)
#define log_step INP(10)
#define b_re INP(11)
#define b_im INP(12)
#define c_re INP(13)
#define c_im INP(14)
#define d_skip INP(15)
#define w_glu INP(16)
#define b_glu INP(17)
#define w_out INP(18)
#define g_mix_post INP(19)
#define g_ffn_pre INP(20)
#define w_ff1 INP(21)
#define w_ff2 INP(22)
#define g_ffn_post INP(23)
    float* out = args.out;
    bf16* WT_in = (bf16*)(ws + WS_WIN); bf16* WT_o = (bf16*)(ws + WS_WO); bf16* WT_glu = (bf16*)(ws + WS_WGLU); bf16* WT_out = (bf16*)(ws + WS_WOUT);
    bf16* WT_ff1 = (bf16*)(ws + WS_WFF1); bf16* WT_ff2 = (bf16*)(ws + WS_WFF2); bf16* TZ = (bf16*)(ws + WS_TZ); bf16* MS = (bf16*)(ws + WS_MS);
    bf16* XN = (bf16*)(ws + WS_XN); bf16* OG = XN; bf16* HN = XN;
    bf16* Qb = (bf16*)(ws + WS_Q); bf16* Kb = (bf16*)(ws + WS_K); bf16* Vb = (bf16*)(ws + WS_V); bf16* SR = (bf16*)(ws + WS_SR); bf16* LAb = (bf16*)(ws + WS_LA); bf16* UH = (bf16*)(ws + WS_UH);
    bf16* GS = (bf16*)(ws + WS_GS); bf16* YG = (bf16*)(ws + WS_YG); bf16* MIX = (bf16*)(ws + WS_MIX); float* T1 = (float*)(ws + WS_T);
    bf16* F1 = (bf16*)(ws + WS_F1); float* T2 = (float*)(ws + WS_T2);
    bf16* SZG = (bf16*)out; bf16* SZS = (bf16*)out + (size_t)M * D;
    float* KM = (float*)(ws + WS_SMALL + SM_KM); float* VM = (float*)(ws + WS_SMALL + SM_VM); float* AL = (float*)(ws + WS_SMALL + SM_AL);
    float* UM = (float*)(ws + WS_SMALL + SM_UM); float* L16 = (float*)(ws + WS_SMALL + SM_L16);
    float* HM = (float*)(ws + WS_SMALL + SM_HM);
    float* DS = (float*)(ws + WS_DS); float* DD = (float*)(ws + WS_DS + 32 * MiB);

    for (int u = wave * 64 + LANE_ID(); u < (LDS_BYTES - LDSCTL_OFF) / 4; u += NWAVES * 64) ((LAS unsigned*)(lds + LDSCTL_OFF))[u] = 0u;
    __syncthreads();
    XcdBarrier bar; bar.bar = ctl + CW_BAR; bar.x = 0; bar.st = nullptr;
    if (N_LAUNCHES == 1) bar = xcd_barrier_post(ctl + CW_BAR, MISC + 8, T0());
    const int lo = args.ph_lo, hi = args.ph_hi;
#define IN(k) (lo <= (k) && (k) < hi)
#define SEAM(k) do { if (IN(k) && IN((k) + 1)) xcd_barrier(bar, T0()); } while (0)

    if (IN(0)) for (int rep_ = 0; rep_ <= ((PROBE_REP_MASK >> 0) & 1); ++rep_) {
        PHASE_IDS();
        if (vcu < 41) {
            const float* meta_p = meta_tokens; const float* gpre_p = g_mix_pre; const float* w_in_p = w_in;
            LAS float* XNM = (LAS float*)lds;
            LAS float* PART = (LAS float*)(lds + 65536);
#pragma unroll
            for (int rr = 0; rr < 2; ++rr) { const int row = 2 * wave + rr;
                const GAS f32x4* xr = (const GAS f32x4*)(meta_p + (size_t)row * D) + lane; const GAS f32x4* gr = (const GAS f32x4*)gpre_p + lane;
                f32x4 v[4]; float s = 0.f;
#pragma unroll
                for (int j = 0; j < 4; ++j) { v[j] = xr[64 * j]; s += (v[j].x * v[j].x + v[j].y * v[j].y) + (v[j].z * v[j].z + v[j].w * v[j].w); }
                const float rs = 1.0f / sqrtf(wave_sum(s) * (1.f / 1024.f) + EPS);
#pragma unroll
                for (int j = 0; j < 4; ++j) { const f32x4 g = gr[64 * j]; *(LAS f32x4*)(XNM + row * 1024 + 4 * lane + 256 * j) = (f32x4){v[j].x * rs * g.x, v[j].y * rs * g.y, v[j].z * rs * g.z, v[j].w * rs * g.w}; } }
            LDS_WAIT(); __syncthreads();
            const int it = vcu; int src, ncol; float* dst; int dld, dcol;
            if (it < 8)       { src = 512 + 64 * it;          ncol = 64; dst = KM; dld = 512;  dcol = 64 * it; }
            else if (it < 24) { src = 1024 + 64 * (it - 8);   ncol = 64; dst = VM; dld = 1024; dcol = 64 * (it - 8); }
            else if (it == 24){ src = SRC_A;                  ncol = 16; dst = AL; dld = 16;   dcol = 0; }
            else              { src = SRC_U + 64 * (it - 25); ncol = 64; dst = UM; dld = 1024; dcol = 64 * (it - 25); }
            float acc[16];
#pragma unroll
            for (int rr = 0; rr < 16; ++rr) acc[rr] = 0.f;
            const bool colok = lane < ncol;
            for (int k4 = 0; k4 < 32; ++k4) { const int k = 128 * wave + 4 * k4;
                float wv[4];
#pragma unroll
                for (int e = 0; e < 4; ++e) wv[e] = colok ? w_in_p[(size_t)(k + e) * IN_W + src + lane] : 0.f;
#pragma unroll
                for (int rr = 0; rr < 16; ++rr) { const f32x4 xv = *(const LAS f32x4*)(XNM + rr * 1024 + k); acc[rr] += (xv.x * wv[0] + xv.y * wv[1]) + (xv.z * wv[2] + xv.w * wv[3]); } }
#pragma unroll
            for (int rr = 0; rr < 16; ++rr) PART[(wave * 16 + rr) * 64 + lane] = acc[rr];
            LDS_WAIT(); __syncthreads();
#pragma unroll
            for (int e = 0; e < 2; ++e) { const int idx = tid + 512 * e, rr = idx >> 6, col = idx & 63; float s = 0.f;
#pragma unroll
                for (int w = 0; w < 8; ++w) s += PART[(w * 16 + rr) * 64 + col];
                if (col < ncol) dst[rr * dld + dcol + col] = s; }
            LDS_WAIT(); __syncthreads();
        }
        LAS float* scr = (LAS float*)(lds + wave * 17408);
        constexpr int I_IN = 192 * 16, I_O = 32 * 16, I_GLU = 64 * 16, I_OUT = 32 * 16, I_FF1 = 128 * 16, I_FF2 = 32 * 64;
        constexpr int I_WA = 8 * 128, I_SSM = 64 * 16, I_T = I_IN + I_O + I_GLU + I_OUT + I_FF1 + I_FF2;
        if (gw < I_SSM) {
            const float* a_re_p = a_re; const float* a_im_p = a_im; const float* ls_p = log_step; const float* b_re_p = b_re; const float* b_im_p = b_im;
            const float* c_re_p = c_re; const float* c_im_p = c_im; const float* dsk_p = d_skip;
            const int g = gw >> 4, d = gw & 15, n = lane;
            LAS float* BBr = scr;
            LAS float* BBi = scr + 1024;
            LAS float* CWr = scr + 2048;
            LAS float* CWi = scr + 2048 + 1040;
            const float ar = a_re_p[g * SN + n], ai = a_im_p[g * SN + n], dt = expf(ls_p[g]);
            const float mag = expf(ar * dt), lr = mag * cosf(ai * dt), li = mag * sinf(ai * dt);
            const float zr = lr - 1.0f, zi = li, den = ar * ar + ai * ai, fre = (zr * ar + zi * ai) / den, fim = (zi * ar - zr * ai) / den;
            float bbr[16], bbi[16];
            { f32x4 br4[4], bi4[4];
#pragma unroll
              for (int q = 0; q < 4; ++q) { br4[q] = *(const GAS f32x4*)(b_re_p + (g * SN + n) * SHG + 4 * q); bi4[q] = *(const GAS f32x4*)(b_im_p + (g * SN + n) * SHG + 4 * q); }
#pragma unroll
              for (int j = 0; j < 16; ++j) { const float br = br4[j >> 2][j & 3], bi = bi4[j >> 2][j & 3];
                bbr[j] = fre * br - fim * bi; bbi[j] = fre * bi + fim * br; BBr[n * 16 + j] = bbr[j]; BBi[n * 16 + j] = bbi[j]; } }
            auto powl = [&](int pw) { const float mg = expf((float)pw * (ar * dt)), an = (float)pw * (ai * dt); return cpx{mg * cosf(an), mg * sinf(an)}; };
            const cpx wd = powl(d), wd1 = powl(d + 1), w15 = powl(15 - d);
            float cr16[16], ci16[16];
#pragma unroll
            for (int i = 0; i < 16; ++i) { cr16[i] = c_re_p[(g * SHG + i) * SN + n]; ci16[i] = c_im_p[(g * SHG + i) * SN + n]; }
#pragma unroll
            for (int i = 0; i < 16; ++i) { const cpx cw = cmul(cpx{cr16[i], ci16[i]}, wd); CWr[i * 65 + n] = cw.r; CWi[i * 65 + n] = cw.i; }
            LDS_WAIT(); asm volatile("" ::: "memory");
            {
                const int i = lane >> 2, j0 = (lane & 3) * 4; float a4[4] = {0.f, 0.f, 0.f, 0.f};
#pragma unroll 8
                for (int nn = 0; nn < SN; ++nn) { const float cwr = CWr[i * 65 + nn], cwi = CWi[i * 65 + nn];
                    const f32x4 br = *(const LAS f32x4*)(BBr + nn * 16 + j0), bi = *(const LAS f32x4*)(BBi + nn * 16 + j0);
#pragma unroll
                    for (int e = 0; e < 4; ++e) a4[e] += cwr * br[e] - cwi * bi[e]; }
                if (d == 0) {
#pragma unroll
                    for (int e = 0; e < 4; ++e) if (i == j0 + e) a4[e] += dsk_p[g * SHG + i]; }
                const v2u val = (v2u){pk2(a4[0], a4[1]), pk2(a4[2], a4[3])}, zero = (v2u){0u, 0u};
                for (int t = d; t < 16; ++t) *(GAS v2u*)(TZ + (size_t)(g * 256 + 16 * t + i) * 384 + 16 * (t - d) + j0) = val;
                if (d >= 1) for (int t = 0; t + d < 16; ++t) *(GAS v2u*)(TZ + (size_t)(g * 256 + 16 * t + i) * 384 + 16 * (t + d) + j0) = zero;
            }
#pragma unroll
            for (int i = 0; i < 16; ++i) { const cpx cl = cmul(cpx{cr16[i], ci16[i]}, wd1);
                TZ[(size_t)(g * 256 + 16 * d + i) * 384 + 256 + n] = (bf16)f2bf(cl.r); TZ[(size_t)(g * 256 + 16 * d + i) * 384 + 320 + n] = (bf16)f2bf(-cl.i); }
            { unsigned pr[8], pi[8];
#pragma unroll
                for (int j = 0; j < 16; j += 2) { const cpx v0 = cmul(w15, cpx{bbr[j], bbi[j]}), v1 = cmul(w15, cpx{bbr[j + 1], bbi[j + 1]}); pr[j >> 1] = pk2(v0.r, v1.r); pi[j >> 1] = pk2(v0.i, v1.i); }
                GAS v4u* p0 = (GAS v4u*)(MS + (size_t)(g * 128 + n) * 256 + 16 * d); p0[0] = (v4u){pr[0], pr[1], pr[2], pr[3]}; p0[1] = (v4u){pr[4], pr[5], pr[6], pr[7]};
                GAS v4u* p1 = (GAS v4u*)(MS + (size_t)(g * 128 + 64 + n) * 256 + 16 * d); p1[0] = (v4u){pi[0], pi[1], pi[2], pi[3]}; p1[1] = (v4u){pi[4], pi[5], pi[6], pi[7]}; }
            if (d == 0) { const cpx w16 = powl(16); L16[(g * SN + n) * 2] = w16.r; L16[(g * SN + n) * 2 + 1] = w16.i; }
            LDS_WAIT(); asm volatile("" ::: "memory");
        }
        if (gw >= NGW - I_WA) {
            const float* w_in_p = w_in; const float* wgu_p = w_gate_up;
            const int r = gw - (NGW - I_WA), nb = r >> 7, kb = r & 127, n = 64 * nb + lane;
            float wg[16];
#pragma unroll
            for (int rr = 0; rr < 16; ++rr) wg[rr] = wgu_p[rr * GKEY + n];
            float o8[8];
#pragma unroll
            for (int e = 0; e < 8; ++e) { const float* wr_ = w_in_p + (size_t)(8 * kb + e) * IN_W + SRC_A; float sacc = 0.f;
#pragma unroll
                for (int rr = 0; rr < 16; ++rr) sacc += wr_[rr] * wg[rr];
                o8[e] = sacc; }
            *(GAS v4u*)(WT_in + (size_t)(6144 + n) * D + 8 * kb) = (v4u){pk2(o8[0], o8[1]), pk2(o8[2], o8[3]), pk2(o8[4], o8[5]), pk2(o8[6], o8[7])};
        }
        {
            const float* w_in_p = w_in; const float* w_o_p = w_o_gla; const float* w_glu_p = w_glu; const float* w_out_p = w_out; const float* w_ff1_p = w_ff1; const float* w_ff2_p = w_ff2;
            for (int it = gw; it < I_T; it += NGW) {
                int r = it;
                if (r < I_IN) { const int rb = r >> 4, kb = r & 15, d0 = 32 * rb; p0_transpose_item(w_in_p, IN_W, d0 < 3072 ? d0 : d0 + 16, D, WT_in, d0, scr, kb, lane); continue; } r -= I_IN;
                if (r < I_O) { const int rb = r >> 4, kb = r & 15; p0_transpose_item(w_o_p, D, 32 * rb, GVAL, WT_o, 32 * rb, scr, kb, lane); continue; } r -= I_O;
                if (r < I_GLU) { const int rb = r >> 4, kb = r & 15, d0 = 32 * rb, pn = d0 >> 8, wi = d0 & 255;
                    p0_transpose_item(w_glu_p, 2 * D, wi < 128 ? 128 * pn + wi : 1024 + 128 * pn + (wi - 128), D, WT_glu, d0, scr, kb, lane); continue; } r -= I_GLU;
                if (r < I_OUT) { const int rb = r >> 4, kb = r & 15; p0_transpose_item(w_out_p, D, 32 * rb, D, WT_out, 32 * rb, scr, kb, lane); continue; } r -= I_OUT;
                if (r < I_FF1) { const int rb = r >> 4, kb = r & 15; p0_transpose_item(w_ff1_p, FF, 32 * rb, D, WT_ff1, 32 * rb, scr, kb, lane); continue; } r -= I_FF1;
                { const int rb = r >> 6, kb = r & 63; p0_transpose_item(w_ff2_p, D, 32 * rb, FF, WT_ff2, 32 * rb, scr, kb, lane); }
            }
        }
        {
            const float* xp = x_in; const float* gp = g_mix_pre;
            const GAS f32x4* gr = (const GAS f32x4*)gp + lane;
            f32x4 gv[4];
#pragma unroll
            for (int j = 0; j < 4; ++j) gv[j] = gr[64 * j];
            const int gw2 = (vcu - 41) * NWAVES + wave, NGW2 = (G - 41) * NWAVES;
            if (vcu >= 41)
            for (int m = gw2; m < M; m += 2 * NGW2) {
                const int m2 = (m + NGW2 < M) ? m + NGW2 : m;
                const GAS f32x4* xa = (const GAS f32x4*)(xp + (size_t)m * D) + lane; const GAS f32x4* xb = (const GAS f32x4*)(xp + (size_t)m2 * D) + lane;
                f32x4 va[4], vb[4]; float sa = 0.f, sb = 0.f;
#pragma unroll
                for (int j = 0; j < 4; ++j) { va[j] = xa[64 * j]; vb[j] = xb[64 * j]; }
#pragma unroll
                for (int j = 0; j < 4; ++j) { sa += (va[j].x * va[j].x + va[j].y * va[j].y) + (va[j].z * va[j].z + va[j].w * va[j].w); sb += (vb[j].x * vb[j].x + vb[j].y * vb[j].y) + (vb[j].z * vb[j].z + vb[j].w * vb[j].w); }
                const float ra = 1.0f / sqrtf(wave_sum(sa) * (1.f / 1024.f) + EPS), rb = 1.0f / sqrtf(wave_sum(sb) * (1.f / 1024.f) + EPS);
                GAS unsigned long long* oa = (GAS unsigned long long*)(XN + (size_t)m * D) + lane; GAS unsigned long long* ob = (GAS unsigned long long*)(XN + (size_t)m2 * D) + lane;
#pragma unroll
                for (int j = 0; j < 4; ++j) {
                    oa[64 * j] = (unsigned long long)pk2(va[j].x * ra * gv[j].x, va[j].y * ra * gv[j].y) | ((unsigned long long)pk2(va[j].z * ra * gv[j].z, va[j].w * ra * gv[j].w) << 32);
                    ob[64 * j] = (unsigned long long)pk2(vb[j].x * rb * gv[j].x, vb[j].y * rb * gv[j].y) | ((unsigned long long)pk2(vb[j].z * rb * gv[j].z, vb[j].w * rb * gv[j].w) << 32); }
            }
        }
    }
    SEAM(0);

    if (IN(1)) for (int rep_ = 0; rep_ <= ((PROBE_REP_MASK >> 1) & 1); ++rep_) {
        pg8::Gemm g{XN, WT_in, D, D, D, 256}; pg8::StaticOrder S; S.init(M, NIN, G, bx);
        pg8::EpiIn E{Qb, Kb, Vb, SR, UH, SZG, SZS, LAb, b_gate};
        pg8::gemm_phase<pg8::EpiIn, pg8::StaticOrder, true>(lds, g, S, E, wave);
    }
    SEAM(1);

    if (IN(2)) {
        for (int rep_ = 0; rep_ <= ((PROBE_REP_MASK >> 2) & 1); ++rep_)
        { pg8::Gemm g{UH, MS, 384, 256, 256, 128}; pg8::GroupOrder S{G, bx};
          pg8::EpiE E{UH};
          pg8::gemm_phase<pg8::EpiE, pg8::GroupOrder, true>(lds, g, S, E, wave); }
        for (int rep_ = 0; rep_ <= ((PROBE_REP_MASK >> 11) & 1); ++rep_)
        { PHASE_IDS();
          const int u = vcu & 255, bh = u >> 3, seg = u & 7;
            if (seg < 7) {
                const int b = bh >> 2, h = bh & 3, mf = b * SEQ + seg * 512;
                f32x16 S[4];
#pragma unroll
                for (int kt = 0; kt < 4; ++kt)
#pragma unroll
                    for (int j = 0; j < 16; ++j) S[kt][j] = 0.f;
                float dsum = 0.f; gla::Pref pf;
                gla::prefetch<false>(pf, Qb, Kb, LAb, Vb, mf, h, tid);
                for (int c = 0; c < 8; ++c)
                    gla::chunk<false>(lds, Qb, Kb, LAb, Vb, SR, nullptr, OG, mf + 64 * c, c < 7 ? mf + 64 * (c + 1) : -1, h, S, pf, dsum, tid, wave, lane);
                float* ds = DS + (size_t)(bh * 7 + seg) * (16 * 2048);
#pragma unroll
                for (int kt = 0; kt < 4; ++kt)
#pragma unroll
                    for (int g4 = 0; g4 < 4; ++g4) *(GAS f32x4*)(ds + ((kt * 4 + g4) * 512 + tid) * 4) = (f32x4){S[kt][4 * g4], S[kt][4 * g4 + 1], S[kt][4 * g4 + 2], S[kt][4 * g4 + 3]};
                if (tid < 128) DD[(bh * 7 + seg) * 128 + tid] = dsum;
            } else if (wave < 2) {
                const int g = 2 * bh + wave, n = lane; float hr = 0.f, hi_ = 0.f;
                const bf16* m0p = MS + (size_t)(g * 128 + n) * 256; const bf16* m1p = MS + (size_t)(g * 128 + 64 + n) * 256;
                for (int kb = 0; kb < 32; ++kb) { const v4u a = *(const GAS v4u*)(m0p + 8 * kb), c4 = *(const GAS v4u*)(m1p + 8 * kb);
                    const float* up = UM + (kb >> 1) * D + g * SHG + (kb & 1) * 8;
                    const f32x4 u0 = *(const GAS f32x4*)up, u1 = *(const GAS f32x4*)(up + 4);
                    hr += (pg8::bflo(a.x) * u0[0] + pg8::bfhi(a.x) * u0[1]) + (pg8::bflo(a.y) * u0[2] + pg8::bfhi(a.y) * u0[3]) + (pg8::bflo(a.z) * u1[0] + pg8::bfhi(a.z) * u1[1]) + (pg8::bflo(a.w) * u1[2] + pg8::bfhi(a.w) * u1[3]);
                    hi_ += (pg8::bflo(c4.x) * u0[0] + pg8::bfhi(c4.x) * u0[1]) + (pg8::bflo(c4.y) * u0[2] + pg8::bfhi(c4.y) * u0[3]) + (pg8::bflo(c4.z) * u1[0] + pg8::bfhi(c4.z) * u1[1]) + (pg8::bflo(c4.w) * u1[2] + pg8::bfhi(c4.w) * u1[3]); }
                HM[g * 128 + n] = hr; HM[g * 128 + 64 + n] = hi_;
            }
        }
        __syncthreads();
    }
    SEAM(2);

    if (IN(3)) {
        for (int rep_ = 0; rep_ <= ((PROBE_REP_MASK >> 10) & 1); ++rep_)
        {
            PHASE_IDS();
            LAS bf16* EL = (LAS bf16*)lds;
#pragma unroll
            for (int pp = 0; pp < 2; ++pp) { const int p = (2 * vcu + pp) & 511, b = p >> 6, g = p & 63; const bf16* src = UH + (size_t)(g * 2048 + b * 256) * 384 + 256;
                v4u tmp[8];
#pragma unroll
                for (int it = 0; it < 8; ++it) { const int idx = tid + 512 * it, c = idx >> 4, pc = idx & 15; tmp[it] = *(const GAS v4u*)(src + (size_t)c * 384 + pc * 8); }
#pragma unroll
                for (int it = 0; it < 8; ++it) { const int idx = tid + 512 * it, c = idx >> 4, pc = idx & 15; *(LAS v4u*)(EL + (pp * 256 + c) * 128 + pc * 8) = tmp[it]; } }
            LDS_WAIT(); __syncthreads();
            if (wave < 2) {
                const int p = (2 * vcu + wave) & 511, g = p & 63, n = lane;
                float hr = HM[g * 128 + n], hi_ = HM[g * 128 + 64 + n];
                const float lr = L16[(g * SN + n) * 2], li = L16[(g * SN + n) * 2 + 1];
                LAS bf16* el = EL + wave * 256 * 128 + n;
#pragma unroll 8
                for (int c = 0; c < 256; ++c) { const float er = bf2f(el[c * 128]), ei = bf2f(el[c * 128 + 64]);
                    el[c * 128] = (bf16)f2bf(hr); el[c * 128 + 64] = (bf16)f2bf(hi_);
                    const float nr = lr * hr - li * hi_ + er, ni = lr * hi_ + li * hr + ei; hr = nr; hi_ = ni; }
            }
            LDS_WAIT(); __syncthreads();
            if (rep_ == ((PROBE_REP_MASK >> 10) & 1))
#pragma unroll
            for (int pp = 0; pp < 2; ++pp) { const int p = (2 * vcu + pp) & 511, b = p >> 6, g = p & 63; bf16* dst = UH + (size_t)(g * 2048 + b * 256) * 384 + 256;
                for (int idx = tid; idx < 256 * 16; idx += 512) { const int c = idx >> 4, pc = idx & 15; *(GAS v4u*)(dst + (size_t)c * 384 + pc * 8) = *(const LAS v4u*)(EL + (pp * 256 + c) * 128 + pc * 8); } }
            LDS_WAIT(); __syncthreads();
        }
        for (int rep_ = 0; rep_ <= ((PROBE_REP_MASK >> 3) & 1); ++rep_)
        { PHASE_IDS();
          const int u = vcu & 255, bh = u >> 3, seg = u & 7, b = bh >> 2, h = bh & 3, mf = b * SEQ + seg * 512;
            for (int i = tid; i < 64 * gla::PP / 2; i += 512) ((LAS unsigned*)(lds + gla::O_P))[i] = 0u;
            f32x16 S[4];
            gla::meta_state(lds, KM, VM, AL, w_gate_up, b_gate, h, S, tid, wave, lane);
            for (int j = 0; j < seg; ++j) {
                const float* ds = DS + (size_t)(bh * 7 + j) * (16 * 2048); const float* dd = DD + (bh * 7 + j) * 128;
#pragma unroll
                for (int kt = 0; kt < 4; ++kt)
#pragma unroll
                    for (int g4 = 0; g4 < 4; ++g4) { const f32x4 a = *(const GAS f32x4*)(ds + ((kt * 4 + g4) * 512 + tid) * 4), d4 = *(const GAS f32x4*)(dd + 32 * kt + 8 * g4 + 4 * (lane >> 5));
#pragma unroll
                        for (int e = 0; e < 4; ++e) S[kt][4 * g4 + e] = __expf(d4[e]) * S[kt][4 * g4 + e] + a[e]; }
            }
            float dsum = 0.f; gla::Pref pf; const float* gn_p = gla_norm_g;
            gla::prefetch<true>(pf, Qb, Kb, LAb, Vb, mf, h, tid);
            for (int c = 0; c < 8; ++c)
                gla::chunk<true>(lds, Qb, Kb, LAb, Vb, SR, gn_p, OG, mf + 64 * c, c < 7 ? mf + 64 * (c + 1) : -1, h, S, pf, dsum, tid, wave, lane);
            __syncthreads();
        }
    }
    SEAM(3);

    if (IN(4)) for (int rep_ = 0; rep_ <= ((PROBE_REP_MASK >> 4) & 1); ++rep_) {
        { pg8::Gemm g{UH, TZ, 384, 384, 384, 256}; pg8::GroupOrder S{G, bx}; pg8::EpiS E{GS};
          pg8::gemm_phase<pg8::EpiS, pg8::GroupOrder, true>(lds, g, S, E, wave); }
        { pg8::Gemm g{OG, WT_o, D, D, D, 256}; pg8::StaticOrder S; S.init(M, D, G, bx); pg8::EpiYG E{SZG, YG};
          pg8::gemm_phase<pg8::EpiYG, pg8::StaticOrder, true>(lds, g, S, E, wave); }
    }
    SEAM(4);

    if (IN(5)) for (int rep_ = 0; rep_ <= ((PROBE_REP_MASK >> 5) & 1); ++rep_) {
        pg8::Gemm g{GS, WT_glu, D, D, D, 256}; pg8::StaticOrder S; S.init(M, 2 * D, G, bx); pg8::EpiGlu E{YG, SZS, MIX, b_glu};
        pg8::gemm_phase<pg8::EpiGlu, pg8::StaticOrder, true>(lds, g, S, E, wave);
    }
    SEAM(5);

    if (IN(6)) for (int rep_ = 0; rep_ <= ((PROBE_REP_MASK >> 6) & 1); ++rep_) {
        pg8::Gemm g{MIX, WT_out, D, D, D, 256}; pg8::StaticOrder S; S.init(M, D, G, bx); pg8::EpiF32 E{T1, D};
        pg8::gemm_phase<pg8::EpiF32, pg8::StaticOrder, true>(lds, g, S, E, wave);
    }
    SEAM(6);

    if (IN(7)) for (int rep_ = 0; rep_ <= ((PROBE_REP_MASK >> 7) & 1); ++rep_) {
        PHASE_IDS();
        const float* xp = x_in; const float* gpost_p = g_mix_post; const float* gfpre_p = g_ffn_pre;
        for (int m = gw; m < M; m += NGW) {
            const GAS f32x4* tr = (const GAS f32x4*)(T1 + (size_t)m * D) + lane; const GAS f32x4* xr = (const GAS f32x4*)(xp + (size_t)m * D) + lane;
            const GAS f32x4* g1 = (const GAS f32x4*)gpost_p + lane; const GAS f32x4* g2 = (const GAS f32x4*)gfpre_p + lane;
            f32x4 v[4]; float s = 0.f;
#pragma unroll
            for (int j = 0; j < 4; ++j) { v[j] = tr[64 * j]; s += (v[j].x * v[j].x + v[j].y * v[j].y) + (v[j].z * v[j].z + v[j].w * v[j].w); }
            const float rs = 1.0f / sqrtf(wave_sum(s) * (1.f / 1024.f) + EPS); float s2 = 0.f;
#pragma unroll
            for (int j = 0; j < 4; ++j) { const f32x4 g = g1[64 * j], xv = xr[64 * j]; v[j] = (f32x4){xv.x + v[j].x * rs * g.x, xv.y + v[j].y * rs * g.y, xv.z + v[j].z * rs * g.z, xv.w + v[j].w * rs * g.w};
                s2 += (v[j].x * v[j].x + v[j].y * v[j].y) + (v[j].z * v[j].z + v[j].w * v[j].w);
                *((GAS f32x4*)(out + (size_t)m * D) + lane + 64 * j) = v[j]; }
            const float rs2 = 1.0f / sqrtf(wave_sum(s2) * (1.f / 1024.f) + EPS);
            GAS unsigned long long* o8 = (GAS unsigned long long*)(HN + (size_t)m * D) + lane;
#pragma unroll
            for (int j = 0; j < 4; ++j) { const f32x4 g = g2[64 * j];
                o8[64 * j] = (unsigned long long)pk2(v[j].x * rs2 * g.x, v[j].y * rs2 * g.y) | ((unsigned long long)pk2(v[j].z * rs2 * g.z, v[j].w * rs2 * g.w) << 32); }
        }
    }
    SEAM(7);

    if (IN(8)) for (int rep_ = 0; rep_ <= ((PROBE_REP_MASK >> 8) & 1); ++rep_) {
        pg8::Gemm g{HN, WT_ff1, D, D, D, 256}; pg8::StaticOrder S; S.init(M, FF, G, bx); pg8::EpiRelu2 E{F1, FF};
        pg8::gemm_phase<pg8::EpiRelu2, pg8::StaticOrder, true>(lds, g, S, E, wave);
    }
    SEAM(8);

    if (IN(9)) for (int rep_ = 0; rep_ <= ((PROBE_REP_MASK >> 9) & 1); ++rep_) {
        pg8::Gemm g{F1, WT_ff2, FF, FF, FF, 256}; pg8::StaticOrder S; S.init(M, D, G, bx); pg8::EpiF32 E{T2, D};
        pg8::gemm_phase<pg8::EpiF32, pg8::StaticOrder, true>(lds, g, S, E, wave);
    }
    SEAM(9);

    if (IN(10)) {
        PHASE_IDS();
        const float* gfpost_p = g_ffn_post;
        for (int m = gw; m < M; m += NGW) {
            const GAS f32x4* tr = (const GAS f32x4*)(T2 + (size_t)m * D) + lane; GAS f32x4* orow = (GAS f32x4*)(out + (size_t)m * D) + lane;
            const GAS f32x4* g1 = (const GAS f32x4*)gfpost_p + lane;
            f32x4 v[4]; float s = 0.f;
#pragma unroll
            for (int j = 0; j < 4; ++j) { v[j] = tr[64 * j]; s += (v[j].x * v[j].x + v[j].y * v[j].y) + (v[j].z * v[j].z + v[j].w * v[j].w); }
            const float rs = 1.0f / sqrtf(wave_sum(s) * (1.f / 1024.f) + EPS);
#pragma unroll
            for (int j = 0; j < 4; ++j) { const f32x4 g = g1[64 * j], hv = orow[64 * j];
                orow[64 * j] = (f32x4){hv.x + v[j].x * rs * g.x, hv.y + v[j].y * rs * g.y, hv.z + v[j].z * rs * g.z, hv.w + v[j].w * rs * g.w}; }
        }
    }
#undef IN
#undef SEAM
#undef x_in
#undef meta_tokens
#undef g_mix_pre
#undef w_in
#undef w_gate_up
#undef b_gate
#undef gla_norm_g
#undef w_o_gla
#undef a_re
#undef a_im
#undef log_step
#undef b_re
#undef b_im
#undef c_re
#undef c_im
#undef d_skip
#undef w_glu
#undef b_glu
#undef w_out
#undef g_mix_post
#undef g_ffn_pre
#undef w_ff1
#undef w_ff2
#undef g_ffn_post
}

extern "C" void kernel_launch(void* const* d_in, const int* in_sizes, int n_in, void* d_out, int out_size, void* d_ws, size_t ws_size, hipStream_t stream) {
    static int grid = 0;
    if (grid == 0) {
        if (n_in != 24 || in_sizes[0] != M * D || out_size != M * D || ws_size < WS_END) { fprintf(stderr, "kernel_launch: unexpected shapes (n_in %d, in0 %d, out %d, ws %zu)\n", n_in, n_in > 0 ? in_sizes[0] : -1, out_size, ws_size); grid = -1; return; }
        int dev = 0, cus = 0;
        if (hipGetDevice(&dev) != hipSuccess || hipDeviceGetAttribute(&cus, hipDeviceAttributeMultiprocessorCount, dev) != hipSuccess) { grid = -1; return; }
        if (hipFuncSetAttribute((const void*)fwd_kernel, hipFuncAttributeMaxDynamicSharedMemorySize, LDS_BYTES) != hipSuccess) { fprintf(stderr, "kernel_launch: hipFuncSetAttribute failed\n"); grid = -1; return; }
        int per_cu = 0;
        if (hipOccupancyMaxActiveBlocksPerMultiprocessor(&per_cu, (const void*)fwd_kernel, NWAVES * 64, LDS_BYTES) != hipSuccess || per_cu < 1) fprintf(stderr, "kernel_launch: occupancy query says %d\n", per_cu);
        (void)hipGetLastError();
        if (cus < 256) { fprintf(stderr, "kernel_launch: this kernel needs 256 CUs (one resident workgroup each), device has %d\n", cus); grid = -1; return; }
        grid = 256;
    }
    if (grid < 0) return;
    if (hipMemsetAsync((char*)d_ws + WS_CTL, 0, CTL_ZERO_BYTES, stream) != hipSuccess) return;
    Args a{};
    for (int i = 0; i < 24; ++i) a.in[i] = (const float*)d_in[i];
    a.out = (float*)d_out; a.ws = (unsigned char*)d_ws;
    if (N_LAUNCHES == 1) {
        a.ph_lo = 0; a.ph_hi = N_PHASES; a.li = 0;
        hipLaunchKernelGGL(fwd_kernel, dim3(grid), dim3(NWAVES * 64), LDS_BYTES, stream, a);
    } else {
        for (int li = 0; li < N_PHASES; ++li) { a.ph_lo = li; a.ph_hi = li + 1; a.li = li;
            hipLaunchKernelGGL(fwd_kernel, dim3(grid), dim3(NWAVES * 64), LDS_BYTES, stream, a); }
    }
}
```

```cpp
#include <hip/hip_runtime.h>
#include <cstdio>
#include <cstdint>

#ifndef PROBE_REP_MASK
#define PROBE_REP_MASK 0
#endif
#ifndef MK_N_LAUNCHES
#define MK_N_LAUNCHES 1
#endif

namespace pg8 {
#define PG8_LAS __attribute__((address_space(3)))
typedef unsigned short bf16_t;
typedef short bf16x8 __attribute__((ext_vector_type(8)));
typedef float f32x4 __attribute__((ext_vector_type(4)));
typedef float f32x2 __attribute__((ext_vector_type(2)));
typedef unsigned u32x4 __attribute__((ext_vector_type(4)));
constexpr int BM = 256, BK = 64, HALF = 128, HTB = HALF * BK * 2, STAGE_BYTES = 8 * HTB, NXCD = 8, WGM = 8;

__host__ __device__ __forceinline__ int lds_byte(int r, int c) { const int st = (r >> 4) * 2 + (c >> 5), rr = r & 15, cc = c & 31, ob = rr * 64 + cc * 2; return st * 1024 + (ob ^ (((ob >> 9) & 1) << 5)); }
__host__ __device__ __forceinline__ void stage_rc(int b, int& R, int& C) { const int st = b / 1024, sb = b % 1024, swz = sb ^ (((sb >> 9) & 1) << 5); R = (st >> 1) * 16 + swz / 64; C = (st & 1) * 32 + (swz % 64) / 2; }
__host__ __device__ __forceinline__ int perm32(int rho) { const int n = rho >> 4, i = rho & 15; return 8 * (i >> 2) + 4 * n + (i & 3); }

struct Unit { int pm, pn; };
struct Gemm { const bf16_t* A; const bf16_t* Bt; int lda, ldb, K, tstepB_rows; };

struct StaticOrder {
    int nM, nN, nwg, G, c;
    __host__ __device__ void init(int M, int N, int G_, int c_) { nM = M / BM; nN = N / BM; nwg = nM * nN; G = G_; c = c_; }
    __host__ __device__ bool next(int i, Unit& u) const {
        const long L = (long)i * G + c; if (L >= nwg) return false;
        int wgid = (int)L; { const int q = nwg / NXCD, r = nwg % NXCD, xcd = wgid % NXCD, off = wgid / NXCD; wgid = (xcd < r ? xcd * (q + 1) : r * (q + 1) + (xcd - r) * q) + off; }
        const int nig = WGM * nN, gid = wgid / nig, fm = gid * WGM, gsz = (nM - fm) < WGM ? (nM - fm) : WGM;
        u.pm = fm + ((wgid % nig) % gsz); u.pn = (wgid % nig) / gsz; return true;
    }
};
struct GroupOrder {
    int G, c;
    __host__ __device__ bool next(int i, Unit& u) const { const int L = i * G + c; if (L >= 512) return false; u.pm = L; u.pn = L >> 3; return true; }
};

typedef __bf16 bf16x2_t __attribute__((ext_vector_type(2)));
__device__ __forceinline__ unsigned cvt_pk_bf16(float lo, float hi) { f32x2 v = {lo, hi}; bf16x2_t b = __builtin_convertvector(v, bf16x2_t); return __builtin_bit_cast(unsigned, b); }
__device__ __forceinline__ float bflo(unsigned w) { return __uint_as_float(w << 16); }
__device__ __forceinline__ float bfhi(unsigned w) { return __uint_as_float(w & 0xffff0000u); }
__device__ __forceinline__ float sigmoidf_(float x) { return __builtin_amdgcn_rcpf(1.0f + __expf(-x)); }
__device__ __forceinline__ float logsigf_(float x) { return fminf(x, 0.f) - __logf(1.0f + __expf(-fabsf(x))); }
__device__ __forceinline__ float gelu_tanh(float x) { const float z = 0.7978845608028654f * (x + 0.044715f * x * x * x); return x * __builtin_amdgcn_rcpf(1.0f + __expf(-2.0f * z)); }
__device__ __forceinline__ u32x4 pack8(const f32x4& a, const f32x4& b) { u32x4 w; w.x = cvt_pk_bf16(a[0], a[1]); w.y = cvt_pk_bf16(a[2], a[3]); w.z = cvt_pk_bf16(b[0], b[1]); w.w = cvt_pk_bf16(b[2], b[3]); return w; }

struct EpiF32 {
    static constexpr bool PERM = false;
    float* C; int ldc;
    __device__ __forceinline__ void operator()(const f32x4 (&acc)[2][2][4][2], const Unit& u, int wr, int wc, int fr, int fq) const {
        const int row0 = u.pm * BM + wr * 64 + fr, col0 = u.pn * BM + wc * 32 + 4 * fq;
#pragma unroll
        for (int ai = 0; ai < 2; ++ai)
#pragma unroll
            for (int m = 0; m < 4; ++m) { float* rowp = C + (size_t)(row0 + ai * HALF + m * 16) * ldc + col0;
#pragma unroll
                for (int bj = 0; bj < 2; ++bj)
#pragma unroll
                    for (int n = 0; n < 2; ++n) *(f32x4*)(rowp + bj * HALF + n * 16) = acc[ai][bj][m][n]; }
    }
};
struct EpiIn {
    static constexpr bool PERM = true;
    bf16_t *Q, *K, *V, *SR, *UH, *SZG, *SZS, *LA; const float* b_gate;
    template <int KIND>
    __device__ __forceinline__ void run(const f32x4 (&acc)[2][2][4][2], bf16_t* base, int ld, int row0, int col0) const {
#pragma unroll
        for (int bj = 0; bj < 2; ++bj) {
            const int c = col0 + bj * HALF;
            f32x4 b0 = (f32x4){0.f, 0.f, 0.f, 0.f}, b1 = b0;
            if (KIND == 5) { b0 = *(const f32x4*)(b_gate + c); b1 = *(const f32x4*)(b_gate + c + 4); }
#pragma unroll
            for (int ai = 0; ai < 2; ++ai)
#pragma unroll
                for (int m = 0; m < 4; ++m) {
                    const int row = row0 + ai * HALF + m * 16;
                    f32x4 v0 = acc[ai][bj][m][0], v1 = acc[ai][bj][m][1];
                    if (KIND == 0) { v0 = v0 * 0.08838834764831845f; v1 = v1 * 0.08838834764831845f; }
                    if (KIND == 2) {
#pragma unroll
                        for (int j = 0; j < 4; ++j) { v0[j] = v0[j] * sigmoidf_(v0[j]); v1[j] = v1[j] * sigmoidf_(v1[j]); } }
                    if (KIND == 4) {
#pragma unroll
                        for (int j = 0; j < 4; ++j) { v0[j] = sigmoidf_(v0[j]); v1[j] = sigmoidf_(v1[j]); } }
                    if (KIND == 5) {
#pragma unroll
                        for (int j = 0; j < 4; ++j) { v0[j] = logsigf_(v0[j] + b0[j]) * 0.0625f; v1[j] = logsigf_(v1[j] + b1[j]) * 0.0625f; } }
                    bf16_t* p = (KIND == 3) ? base + ((size_t)((c >> 4) * 2048 + (row >> 4)) * 384 + (row & 15) * 16 + (c & 15))
                                            : base + ((size_t)row * ld + c);
                    *(u32x4*)p = pack8(v0, v1);
                }
        }
    }
    __device__ __forceinline__ void operator()(const f32x4 (&acc)[2][2][4][2], const Unit& u, int wr, int wc, int fr, int fq) const {
        const int pn = u.pn; const int row0 = u.pm * BM + wr * 64 + fr, cw = wc * 32 + 8 * fq;
        if (pn < 2)       run<0>(acc, Q, 512, row0, pn * 256 + cw);
        else if (pn < 4)  run<1>(acc, K, 512, row0, (pn - 2) * 256 + cw);
        else if (pn < 8)  run<1>(acc, V, 1024, row0, (pn - 4) * 256 + cw);
        else if (pn < 12) run<2>(acc, SR, 1024, row0, (pn - 8) * 256 + cw);
        else if (pn < 16) run<3>(acc, UH, 0, row0, (pn - 12) * 256 + cw);
        else if (pn < 20) run<4>(acc, SZG, 1024, row0, (pn - 16) * 256 + cw);
        else if (pn < 24) run<4>(acc, SZS, 1024, row0, (pn - 20) * 256 + cw);
        else              run<5>(acc, LA, 512, row0, (pn - 24) * 256 + cw);
    }
};
struct EpiE {
    static constexpr bool PERM = true;
    bf16_t* UH;
    __device__ __forceinline__ void operator()(const f32x4 (&acc)[2][2][4][2], const Unit& u, int wr, int wc, int fr, int fq) const {
        const int row0 = u.pm * BM + wr * 64 + fr, col0 = 256 + wc * 32 + 8 * fq;
#pragma unroll
        for (int ai = 0; ai < 2; ++ai)
#pragma unroll
            for (int m = 0; m < 4; ++m) *(u32x4*)(UH + (size_t)(row0 + ai * HALF + m * 16) * 384 + col0) = pack8(acc[ai][0][m][0], acc[ai][0][m][1]);
    }
};
struct EpiS {
    static constexpr bool PERM = true;
    bf16_t* GS;
    __device__ __forceinline__ void operator()(const f32x4 (&acc)[2][2][4][2], const Unit& u, int wr, int wc, int fr, int fq) const {
        const int g = u.pn; const int rg0 = (u.pm & 7) * BM + wr * 64 + fr;
        bf16_t* base = GS + ((size_t)g * (32768 * 16) + (size_t)rg0 * 256 + wc * 32 + fq * 8);
#pragma unroll
        for (int ai = 0; ai < 2; ++ai)
#pragma unroll
            for (int m = 0; m < 4; ++m) {
#pragma unroll
                for (int bj = 0; bj < 2; ++bj) {
                    f32x4 v0 = acc[ai][bj][m][0], v1 = acc[ai][bj][m][1];
#pragma unroll
                    for (int j = 0; j < 4; ++j) { v0[j] = gelu_tanh(v0[j]); v1[j] = gelu_tanh(v1[j]); }
                    *(u32x4*)(base + (size_t)(ai * HALF + m * 16) * 256 + bj * HALF) = pack8(v0, v1); }
                asm volatile("" ::: "memory"); }
    }
};
struct EpiYG {
    static constexpr bool PERM = true;
    const bf16_t* SZG; bf16_t* YG;
    __device__ __forceinline__ void operator()(const f32x4 (&acc)[2][2][4][2], const Unit& u, int wr, int wc, int fr, int fq) const {
        const int row0 = u.pm * BM + wr * 64 + fr, col0 = u.pn * BM + wc * 32 + 8 * fq;
#pragma unroll
        for (int ai = 0; ai < 2; ++ai)
#pragma unroll
            for (int m = 0; m < 4; ++m)
#pragma unroll
                for (int bj = 0; bj < 2; ++bj) { const size_t off = (size_t)(row0 + ai * HALF + m * 16) * 1024 + col0 + bj * HALF;
                    const u32x4 z = *(const u32x4*)(SZG + off); f32x4 v0 = acc[ai][bj][m][0], v1 = acc[ai][bj][m][1];
                    v0[0] *= bflo(z.x); v0[1] *= bfhi(z.x); v0[2] *= bflo(z.y); v0[3] *= bfhi(z.y); v1[0] *= bflo(z.z); v1[1] *= bfhi(z.z); v1[2] *= bflo(z.w); v1[3] *= bfhi(z.w);
                    *(u32x4*)(YG + off) = pack8(v0, v1); }
    }
};
struct EpiGlu {
    static constexpr bool PERM = true;
    const bf16_t *YG, *SZS; bf16_t* MIX; const float* b_glu;
    __device__ __forceinline__ void operator()(const f32x4 (&acc)[2][2][4][2], const Unit& u, int wr, int wc, int fr, int fq) const {
        const int row0 = u.pm * BM + wr * 64 + fr, c = u.pn * HALF + wc * 32 + 8 * fq;
        const f32x4 bv0 = *(const f32x4*)(b_glu + c), bv1 = *(const f32x4*)(b_glu + c + 4), bg0 = *(const f32x4*)(b_glu + 1024 + c), bg1 = *(const f32x4*)(b_glu + 1024 + c + 4);
#pragma unroll
        for (int ai = 0; ai < 2; ++ai)
#pragma unroll
            for (int m = 0; m < 4; ++m) { const size_t off = (size_t)(row0 + ai * HALF + m * 16) * 1024 + c;
                const u32x4 y = *(const u32x4*)(YG + off), z = *(const u32x4*)(SZS + off);
                f32x4 v0 = acc[ai][0][m][0] + bv0, v1 = acc[ai][0][m][1] + bv1, g0 = acc[ai][1][m][0] + bg0, g1 = acc[ai][1][m][1] + bg1;
#pragma unroll
                for (int j = 0; j < 4; ++j) { v0[j] *= sigmoidf_(g0[j]); v1[j] *= sigmoidf_(g1[j]); }
                v0[0] = bflo(y.x) + bflo(z.x) * v0[0]; v0[1] = bfhi(y.x) + bfhi(z.x) * v0[1]; v0[2] = bflo(y.y) + bflo(z.y) * v0[2]; v0[3] = bfhi(y.y) + bfhi(z.y) * v0[3];
                v1[0] = bflo(y.z) + bflo(z.z) * v1[0]; v1[1] = bfhi(y.z) + bfhi(z.z) * v1[1]; v1[2] = bflo(y.w) + bflo(z.w) * v1[2]; v1[3] = bfhi(y.w) + bfhi(z.w) * v1[3];
                *(u32x4*)(MIX + off) = pack8(v0, v1); }
    }
};
struct EpiRelu2 {
    static constexpr bool PERM = true;
    bf16_t* O; int ldc;
    __device__ __forceinline__ void operator()(const f32x4 (&acc)[2][2][4][2], const Unit& u, int wr, int wc, int fr, int fq) const {
        const int row0 = u.pm * BM + wr * 64 + fr, col0 = u.pn * BM + wc * 32 + 8 * fq;
#pragma unroll
        for (int ai = 0; ai < 2; ++ai)
#pragma unroll
            for (int m = 0; m < 4; ++m)
#pragma unroll
                for (int bj = 0; bj < 2; ++bj) { f32x4 v0 = acc[ai][bj][m][0], v1 = acc[ai][bj][m][1];
#pragma unroll
                    for (int j = 0; j < 4; ++j) { const float a = fmaxf(v0[j], 0.f), b = fmaxf(v1[j], 0.f); v0[j] = a * a; v1[j] = b * b; }
                    *(u32x4*)(O + (size_t)(row0 + ai * HALF + m * 16) * ldc + col0 + bj * HALF) = pack8(v0, v1); }
    }
};

constexpr size_t AGROUP_PLANE = (size_t)32768 * 32;
template <class Epi, class Sched, bool ALIGN_EPI, bool AGROUP = false>
__device__ __forceinline__ void gemm_phase(PG8_LAS unsigned char* lds, const Gemm g, const Sched& S, const Epi& E, const int wid  ) {
    int lane_ = (int)__builtin_amdgcn_mbcnt_hi(~0u, __builtin_amdgcn_mbcnt_lo(~0u, 0u)); asm volatile("" : "+v"(lane_));
    const int lane = lane_, tid = wid * 64 + lane, wr = wid >> 2, wc = wid & 3, fr = lane & 15, fq = lane >> 4;
    const int nt = g.K / BK;
    unsigned voffA[2], voffB[2];
#pragma unroll
    for (int i = 0; i < 2; ++i) { int R, C; stage_rc(tid * 16 + i * 8192, R, C); const int Rb = Epi::PERM ? ((R & ~31) + perm32(R & 31)) : R;
        voffA[i] = AGROUP ? (unsigned)((C >> 4) * (unsigned)AGROUP_PLANE + R * 32 + (C & 15) * 2) : (unsigned)(R * g.lda + C) * 2u; voffB[i] = (unsigned)(Rb * g.ldb + C) * 2u; }
    const size_t kstepB = (size_t)(BK * 2), kstepA = AGROUP ? 4 * AGROUP_PLANE : (size_t)(BK * 2);
    const size_t hstepA = AGROUP ? (size_t)HALF * 32 : (size_t)HALF * g.lda * 2, hstepB = (size_t)HALF * g.ldb * 2;
    const size_t tstepA = 2 * hstepA, tstepB = (size_t)g.tstepB_rows * g.ldb * 2;
    const unsigned ldsw = (unsigned)wid * 1024u;
    const int aoff = lds_byte(wr * 64 + fr, fq * 8), boff = lds_byte(wc * 32 + fr, fq * 8);
#define PG8_SA(b, h) (((b) * 2 + (h)) * HTB)
#define PG8_SB(b, h) ((4 + (b) * 2 + (h)) * HTB)
#define PG8_STAGE(bufoff, gbase, voff) do { _Pragma("unroll") for (int _i = 0; _i < 2; ++_i) \
        __builtin_amdgcn_global_load_lds((const unsigned*)((const char*)(gbase) + (voff)[_i]), (PG8_LAS unsigned*)(lds + (bufoff) + ldsw + _i * 8192), 16, 0, 0); } while (0)
#define PG8_LDA(dst, b, h) do { _Pragma("unroll") for (int m = 0; m < 4; ++m) _Pragma("unroll") for (int k = 0; k < 2; ++k) dst[m][k] = *(const PG8_LAS bf16x8*)(lds + PG8_SA(b, h) + aoff + m * 2048 + k * 1024); } while (0)
#define PG8_LDB(dst, b, h) do { _Pragma("unroll") for (int n = 0; n < 2; ++n) _Pragma("unroll") for (int k = 0; k < 2; ++k) dst[n][k] = *(const PG8_LAS bf16x8*)(lds + PG8_SB(b, h) + boff + n * 2048 + k * 1024); } while (0)
#define PG8_MMA(ai, bj, At, Bt) do { __builtin_amdgcn_s_setprio(1); _Pragma("unroll") for (int m = 0; m < 4; ++m) _Pragma("unroll") for (int n = 0; n < 2; ++n) _Pragma("unroll") for (int k = 0; k < 2; ++k) \
        acc[ai][bj][m][n] = __builtin_amdgcn_mfma_f32_16x16x32_bf16(Bt[n][k], At[m][k], acc[ai][bj][m][n], 0, 0, 0); __builtin_amdgcn_s_setprio(0); } while (0)
#define PG8_WAIT_V(n) asm volatile("s_waitcnt vmcnt(" #n ")" ::: "memory")
#define PG8_WAIT_L(n) asm volatile("s_waitcnt lgkmcnt(" #n ")" ::: "memory")
#define PG8_BAR __builtin_amdgcn_s_barrier()
#define PG8_SCHED __builtin_amdgcn_sched_barrier(0)
    Unit cur, nxt; int ui = 0;
    if (!S.next(0, cur)) return;
    f32x4 acc[2][2][4][2];
#pragma unroll
    for (int a = 0; a < 2; ++a)
#pragma unroll
        for (int b = 0; b < 2; ++b)
#pragma unroll
            for (int m = 0; m < 4; ++m)
#pragma unroll
                for (int n = 0; n < 2; ++n) acc[a][b][m][n] = (f32x4){0.f, 0.f, 0.f, 0.f};
    bf16x8 At[4][2], B0[2][2], B1[2][2];
    const char* cA = (const char*)g.A + (size_t)cur.pm * tstepA; const char* cB = (const char*)g.Bt + (size_t)cur.pn * tstepB;
    PG8_STAGE(PG8_SB(0, 0), cB, voffB); PG8_STAGE(PG8_SB(0, 1), cB + hstepB, voffB); PG8_STAGE(PG8_SA(0, 0), cA, voffA); PG8_STAGE(PG8_SA(0, 1), cA + hstepA, voffA);
    if (wr == 1) PG8_BAR;
    PG8_WAIT_V(2); PG8_BAR;
    PG8_STAGE(PG8_SB(1, 0), cB + kstepB, voffB); PG8_STAGE(PG8_SA(1, 0), cA + kstepA, voffA); PG8_STAGE(PG8_SB(1, 1), cB + hstepB + kstepB, voffB);
    PG8_WAIT_V(6); PG8_BAR;
    for (;;) {
        const bool has_next = S.next(ui + 1, nxt);
        const char* nA = has_next ? (const char*)g.A + (size_t)nxt.pm * tstepA : cA; const char* nB = has_next ? (const char*)g.Bt + (size_t)nxt.pn * tstepB : cB;
        for (int t = 0; t < nt; t += 2) {
            const bool last = (t == nt - 2);
            const char* a1 = cA + (size_t)(t + 1) * kstepA;
            const char* a2 = last ? nA : cA + (size_t)(t + 2) * kstepA; const char* b2 = last ? nB : cB + (size_t)(t + 2) * kstepB;
            const char* a3 = a2 + kstepA; const char* b3 = b2 + kstepB;
            PG8_LDB(B0, 0, 0); PG8_LDB(B1, 0, 1); PG8_SCHED; PG8_LDA(At, 0, 0); PG8_STAGE(PG8_SA(1, 1), a1 + hstepA, voffA);
            PG8_WAIT_V(8); PG8_WAIT_L(0); PG8_BAR; PG8_MMA(0, 0, At, B0); PG8_MMA(0, 1, At, B1); PG8_BAR; PG8_SCHED;
            PG8_LDA(At, 0, 1); PG8_STAGE(PG8_SB(0, 0), b2, voffB); PG8_STAGE(PG8_SB(0, 1), b2 + hstepB, voffB); PG8_STAGE(PG8_SA(0, 0), a2, voffA);
            PG8_WAIT_V(8); PG8_WAIT_L(0); PG8_BAR; PG8_MMA(1, 0, At, B0); PG8_MMA(1, 1, At, B1); PG8_BAR; PG8_SCHED;
            PG8_LDB(B0, 1, 0); PG8_LDB(B1, 1, 1); PG8_SCHED; PG8_LDA(At, 1, 0); PG8_STAGE(PG8_SA(0, 1), a2 + hstepA, voffA);
            PG8_WAIT_V(8); PG8_WAIT_L(0); PG8_BAR; PG8_MMA(0, 0, At, B0); PG8_MMA(0, 1, At, B1); PG8_BAR; PG8_SCHED;
            PG8_LDA(At, 1, 1); PG8_STAGE(PG8_SB(1, 0), b3, voffB); PG8_STAGE(PG8_SB(1, 1), b3 + hstepB, voffB); PG8_STAGE(PG8_SA(1, 0), a3, voffA);
            PG8_WAIT_V(8); PG8_WAIT_L(0); PG8_BAR; PG8_MMA(1, 0, At, B0); PG8_MMA(1, 1, At, B1); PG8_BAR; PG8_SCHED;
        }
        if constexpr (ALIGN_EPI) { if (wr == 0) PG8_BAR; }
        { int le = (int)__builtin_amdgcn_mbcnt_hi(~0u, __builtin_amdgcn_mbcnt_lo(~0u, 0u)); asm volatile("" : "+v"(le)); E(acc, cur, wr, wc, le & 15, le >> 4); }
        if (!has_next) break;
#pragma unroll
        for (int a = 0; a < 2; ++a)
#pragma unroll
            for (int b = 0; b < 2; ++b)
#pragma unroll
                for (int m = 0; m < 4; ++m)
#pragma unroll
                    for (int n = 0; n < 2; ++n) acc[a][b][m][n] = (f32x4){0.f, 0.f, 0.f, 0.f};
        cur = nxt; cA = nA; cB = nB; ++ui;
        if constexpr (ALIGN_EPI) { if (wr == 1) PG8_BAR; }
    }
    PG8_WAIT_V(0);
    if constexpr (!ALIGN_EPI) { if (wr == 0) PG8_BAR; }
    PG8_BAR;
#undef PG8_SA
#undef PG8_SB
#undef PG8_STAGE
#undef PG8_LDA
#undef PG8_LDB
#undef PG8_MMA
#undef PG8_WAIT_V
#undef PG8_WAIT_L
#undef PG8_BAR
#undef PG8_SCHED
}
}

constexpr int NWAVES = 8;
constexpr int BATCH = 8, SEQ = 4096, D = 1024, M = BATCH * SEQ, NMETA = 16;
constexpr int NH = 4, DKH = 128, DVH = 256, GKEY = 512, GVAL = 1024, RANK = 16;
constexpr int SG = 64, SHG = 16, SN = 64, FF = 4096, IN_W = 6160, NIN = 6656;
constexpr int SRC_A = 3072, SRC_U = 3088;
constexpr float EPS = 1e-6f;
constexpr int N_LAUNCHES = MK_N_LAUNCHES;
constexpr int N_PHASES = 11;

constexpr size_t MiB = 1u << 20;
constexpr size_t WS_CTL = 0, CTL_ZERO_BYTES = 1 * MiB;
constexpr size_t WS_SMALL = 1 * MiB;
constexpr size_t WS_WIN = 2 * MiB, WS_WO = 15 * MiB, WS_WGLU = 17 * MiB, WS_WOUT = 21 * MiB, WS_WFF1 = 23 * MiB, WS_WFF2 = 31 * MiB;
constexpr size_t WS_TZ = 39 * MiB;
constexpr size_t WS_MS = 51 * MiB;
constexpr size_t WS_XN = 56 * MiB;
constexpr size_t WS_Q = 120 * MiB, WS_K = 152 * MiB, WS_V = 184 * MiB, WS_SR = 248 * MiB, WS_LA = 312 * MiB, WS_UH = 344 * MiB;
constexpr size_t WS_GS = 120 * MiB;
constexpr size_t WS_YG = 184 * MiB;
constexpr size_t WS_MIX = 248 * MiB;
constexpr size_t WS_T = 312 * MiB;
constexpr size_t WS_F1 = 120 * MiB;
constexpr size_t WS_T2 = 376 * MiB;
constexpr size_t WS_DS = 440 * MiB;
constexpr size_t WS_END = 504 * MiB;
constexpr size_t SM_KM = 0;
constexpr size_t SM_VM = SM_KM + 16 * 512 * 4;
constexpr size_t SM_AL = SM_VM + 16 * 1024 * 4;
constexpr size_t SM_UM = SM_AL + 16 * 16 * 4;
constexpr size_t SM_L16 = SM_UM + 16 * 1024 * 4;
constexpr size_t SM_HM = SM_L16 + 64 * 64 * 2 * 4;
constexpr size_t SM_END = SM_HM + 64 * 128 * 4;
static_assert(SM_END <= MiB, "small region");
constexpr int CW_BAR = 4096;

constexpr int RING_BYTES = 139264;
constexpr int LDSCTL_OFF = RING_BYTES, MISC_OFF = LDSCTL_OFF + 320;
constexpr int LDS_BYTES = 147456;

#define GAS __attribute__((address_space(1)))
#define LAS __attribute__((address_space(3)))
typedef unsigned short bf16;
typedef unsigned v4u __attribute__((ext_vector_type(4)));
typedef unsigned v2u __attribute__((ext_vector_type(2)));
typedef float f32x4 __attribute__((ext_vector_type(4)));
typedef float f32x16 __attribute__((ext_vector_type(16)));
typedef short bf16x8 __attribute__((ext_vector_type(8)));
#define LDS_WAIT() asm volatile("s_waitcnt lgkmcnt(0)" ::: "memory")
#define VM_WAIT() asm volatile("s_waitcnt vmcnt(0)" ::: "memory")
__device__ __forceinline__ unsigned f2bf(float f) { unsigned u = __builtin_bit_cast(unsigned, f); return (u + 0x7fffu + ((u >> 16) & 1u)) >> 16; }
__device__ __forceinline__ unsigned pk2(float lo, float hi) { return f2bf(lo) | (f2bf(hi) << 16); }
__device__ __forceinline__ float bf2f(bf16 b) { return __uint_as_float((unsigned)b << 16); }

#define XB_TMO      128
#define XB_XCNT(j)  (256  + 64 * (j))
#define XB_XSUB(j)  (1280 + 64 * (j))
#define XB_XGEN(j)  (2304 + 64 * (j))
#define XB_TOP      3328
#define XB_TOPGEN   3392
#define XCD_BAR_WORDS 3456
#define XB_SPIN_CAP (1u << 18)
__device__ __forceinline__ unsigned xb_ld(unsigned* p)              { return __hip_atomic_load(p, __ATOMIC_RELAXED, __HIP_MEMORY_SCOPE_AGENT); }
__device__ __forceinline__ unsigned xb_add(unsigned* p, unsigned v) { return __hip_atomic_fetch_add(p, v, __ATOMIC_RELAXED, __HIP_MEMORY_SCOPE_AGENT); }
__device__ __forceinline__ unsigned xb_xcc_id() { return (unsigned)__builtin_amdgcn_s_getreg((3 << 11) | 20) & 0xFu; }
#define XB_SPIN(cond, bar) do { unsigned _sp = 0; while (cond) { __builtin_amdgcn_s_sleep(1); \
    if ((++_sp & 255u) == 0u) { if (xb_ld(&(bar)[XB_TMO])) break; if (_sp > XB_SPIN_CAP) { atomicAdd(&(bar)[XB_TMO], 1u); break; } } } } while (0)
struct XcdBarrier { unsigned* bar; unsigned x; volatile LAS unsigned* st; };
__device__ __forceinline__ XcdBarrier xcd_barrier_post(unsigned* bar, volatile LAS unsigned* st, bool t0) {
    XcdBarrier b; b.bar = bar; b.x = xb_xcc_id(); b.st = st;
    if (t0) (void)xb_add(&bar[XB_XCNT(b.x)], 1u);
    return b;
}
__device__ __forceinline__ void xcd_barrier_complete(unsigned* bar, unsigned x, unsigned& nloc, unsigned& nx) {
    const unsigned G = gridDim.x * gridDim.y * gridDim.z;
    unsigned sum, cnt, mine, sp = 0u;
    for (;;) {
        sum = 0u; cnt = 0u; mine = 0u;
#pragma unroll
        for (unsigned j = 0; j < 16; ++j) { const unsigned c = xb_ld(&bar[XB_XCNT(j)]); sum += c; cnt += (c > 0u) ? 1u : 0u; mine = (j == x) ? c : mine; }
        if (sum == G) break;
        __builtin_amdgcn_s_sleep(1);
        if ((++sp & 255u) == 0u) { if (xb_ld(&bar[XB_TMO])) break; if (sp > XB_SPIN_CAP) { atomicAdd(&bar[XB_TMO], 1u); break; } }
    }
    nloc = mine > 0u ? mine : 1u; nx = cnt > 0u ? cnt : 1u;
}
__device__ __forceinline__ void xcd_barrier(const XcdBarrier& b, bool t0) {
    asm volatile("s_waitcnt vmcnt(0)" ::: "memory");
    __syncthreads();
    if (t0) {
        unsigned* bar = b.bar;
        __builtin_amdgcn_s_waitcnt(0);
        unsigned nloc = b.st[0], nx = b.st[1];
        if (nloc == 0u) { xcd_barrier_complete(bar, b.x, nloc, nx); b.st[0] = nloc; b.st[1] = nx; }
        const unsigned old = xb_add(&bar[XB_XSUB(b.x)], 1u);
        const unsigned gen = old / nloc;
        if (old + 1u == (gen + 1u) * nloc) {
            __builtin_amdgcn_fence(__ATOMIC_RELEASE, "agent");
            asm volatile("s_waitcnt vmcnt(0)" ::: "memory");
            const unsigned og = xb_add(&bar[XB_TOP], 1u);
            const unsigned tg = og / nx;
            if (og + 1u == (tg + 1u) * nx) xb_add(&bar[XB_TOPGEN], 1u);
            else XB_SPIN(xb_ld(&bar[XB_TOPGEN]) == tg, bar);
            __builtin_amdgcn_fence(__ATOMIC_ACQUIRE, "agent");
            xb_add(&bar[XB_XGEN(b.x)], 1u);
            asm volatile("s_waitcnt vmcnt(0)" ::: "memory");
        } else {
            XB_SPIN(xb_ld(&bar[XB_XGEN(b.x)]) == gen, bar);
            __builtin_amdgcn_fence(__ATOMIC_ACQUIRE, "agent");
            asm volatile("s_waitcnt vmcnt(0)" ::: "memory");
        }
    }
    __syncthreads();
}

struct Args { const float* in[24]; float* out; unsigned char* ws; int ph_lo, ph_hi, li, pad; };

__device__ __forceinline__ int launder_idx(int i) { asm volatile("" : "+s"(i)); return i; }
__device__ __forceinline__ float wave_sum(float v) {
#pragma unroll
    for (int o = 1; o < 64; o <<= 1) v += __shfl_xor(v, o);
    return v;
}

__device__ __forceinline__ void p0_transpose_item(const float* W, int ldw, int src_col0, int K, bf16* WT, int dst_row0, LAS float* scr, int kb, int lane, const float* kscale = nullptr) {
    const int k0 = 64 * kb;
    if (kscale) {
#pragma unroll 16
        for (int i = 0; i < 32; ++i) { const int kk = 2 * i + (lane >> 5); scr[kk * 33 + (lane & 31)] = W[(size_t)(k0 + kk) * ldw + src_col0 + (lane & 31)] * kscale[k0 + kk]; }
    } else
#pragma unroll 16
    for (int i = 0; i < 32; ++i) { const int kk = 2 * i + (lane >> 5); scr[kk * 33 + (lane & 31)] = W[(size_t)(k0 + kk) * ldw + src_col0 + (lane & 31)]; }
    LDS_WAIT(); asm volatile("" ::: "memory");
    const int c = lane & 7;
#pragma unroll
    for (int j = 0; j < 4; ++j) { const int n = (lane >> 3) + 8 * j; const LAS float* s = scr + (8 * c) * 33 + n;
        v4u o; o.x = pk2(s[0 * 33], s[1 * 33]); o.y = pk2(s[2 * 33], s[3 * 33]); o.z = pk2(s[4 * 33], s[5 * 33]); o.w = pk2(s[6 * 33], s[7 * 33]);
        *(GAS v4u*)(WT + (size_t)(dst_row0 + n) * K + k0 + 8 * c) = o; }
    LDS_WAIT(); asm volatile("" ::: "memory");
}
__device__ __forceinline__ void rms_row_to_bf16(const float* xrow, const float* gain, bf16* orow, int lane) {
    const GAS f32x4* xr = (const GAS f32x4*)xrow + lane; const GAS f32x4* gr = (const GAS f32x4*)gain + lane;
    f32x4 v[4]; float s = 0.f;
#pragma unroll
    for (int j = 0; j < 4; ++j) { v[j] = xr[64 * j]; s += (v[j].x * v[j].x + v[j].y * v[j].y) + (v[j].z * v[j].z + v[j].w * v[j].w); }
    const float rs = 1.0f / sqrtf(wave_sum(s) * (1.f / 1024.f) + EPS);
    GAS unsigned long long* o8 = (GAS unsigned long long*)orow + lane;
#pragma unroll
    for (int j = 0; j < 4; ++j) { const f32x4 g = gr[64 * j];
        o8[64 * j] = (unsigned long long)pk2(v[j].x * rs * g.x, v[j].y * rs * g.y) | ((unsigned long long)pk2(v[j].z * rs * g.z, v[j].w * rs * g.w) << 32); }
}
struct cpx { float r, i; };
__device__ __forceinline__ cpx cmul(cpx a, cpx b) { return cpx{a.r * b.r - a.i * b.i, a.r * b.i + a.i * b.r}; }

namespace gla {
typedef float f32x2_t __attribute__((ext_vector_type(2))); typedef __bf16 bf16x2_t __attribute__((ext_vector_type(2)));
__device__ __forceinline__ unsigned pk2h(float lo, float hi) { f32x2_t v = {lo, hi}; bf16x2_t b = __builtin_convertvector(v, bf16x2_t); return __builtin_bit_cast(unsigned, b); }
__device__ __forceinline__ bf16 f2bfh(float f) { return (bf16)pk2h(f, 0.f); }
typedef short s16x4 __attribute__((ext_vector_type(4)));
typedef short v4i16_t __attribute__((ext_vector_type(4)));
constexpr int QP = 136, XP = 160, VP = 288, PP = 72, OP = 264;
constexpr int O_QE = 0, O_B = 17408, O_KI = O_B + 33792, O_KX = O_KI + 17408, O_V = O_KX + 64 * XP * 2, O_P = O_V + 64 * VP * 2, O_DK = O_P + 64 * PP * 2, O_TOT = O_DK + 512, O_END = O_TOT + 2048;
static_assert(O_END <= RING_BYTES, "gla lds");
__device__ __forceinline__ s16x4 tr4(const LAS unsigned char* p) { return __builtin_bit_cast(s16x4, __builtin_amdgcn_ds_read_tr16_b64_v4i16((LAS v4i16_t*)p)); }
__device__ __forceinline__ bf16x8 cat8(s16x4 a, s16x4 b) { return __builtin_shufflevector(a, b, 0, 1, 2, 3, 4, 5, 6, 7); }

struct Pref { unsigned la[16]; v4u k[2], q[2], v[4]; };
__device__ __forceinline__ void prefetch_la(Pref& pf, const bf16* __restrict__ LAg, int m0, int h, int tid) {
    const bf16* lp = LAg + (size_t)(m0 + 16 * (tid >> 7)) * GKEY + h * DKH + (tid & 127);
#pragma unroll
    for (int i = 0; i < 16; ++i) pf.la[i] = (unsigned)lp[(size_t)i * GKEY];
}
__device__ __forceinline__ void prefetch_v(Pref& pf, const bf16* __restrict__ Vg, int m0, int h, int tid) {
#pragma unroll
    for (int j = 0; j < 4; ++j) pf.v[j] = *(const GAS v4u*)(Vg + (size_t)(m0 + (tid >> 5) + 16 * j) * GVAL + h * DVH + (tid & 31) * 8);
}
template <bool WANT_O>
__device__ __forceinline__ void prefetch_kq(Pref& pf, const bf16* __restrict__ Qg, const bf16* __restrict__ Kg, int m0, int h, int tid) {
#pragma unroll
    for (int i = 0; i < 2; ++i) { const size_t o = (size_t)(m0 + (tid >> 4) + 32 * i) * GKEY + h * DKH + (tid & 15) * 8;
        pf.k[i] = *(const GAS v4u*)(Kg + o); if (WANT_O) pf.q[i] = *(const GAS v4u*)(Qg + o); }
}
template <bool WANT_O>
__device__ __forceinline__ void prefetch(Pref& pf, const bf16* __restrict__ Qg, const bf16* __restrict__ Kg, const bf16* __restrict__ LAg, const bf16* __restrict__ Vg, int m0, int h, int tid) {
    prefetch_la(pf, LAg, m0, h, tid); prefetch_v(pf, Vg, m0, h, tid); prefetch_kq<WANT_O>(pf, Qg, Kg, m0, h, tid);
}

template <bool WANT_O>
__device__ __forceinline__ void chunk(LAS unsigned char* lds, const bf16* __restrict__ Qg, const bf16* __restrict__ Kg, const bf16* __restrict__ LAg, const bf16* __restrict__ Vg,
                                      const bf16* __restrict__ SRg, const float* __restrict__ gn, bf16* __restrict__ OG, int m0, int m0n, int h, f32x16 (&S)[4], Pref& pf, float& dsum,
                                      int tid_in, int wid, int lane_in) {
    int tid = tid_in; asm volatile("" : "+v"(tid));
    LAS bf16* QE = (LAS bf16*)(lds + O_QE); LAS float* Bm = (LAS float*)(lds + O_B); LAS bf16* OT = (LAS bf16*)(lds + O_B); LAS bf16* KI = (LAS bf16*)(lds + O_KI);
    LAS bf16* KX = (LAS bf16*)(lds + O_KX); LAS bf16* Vs = (LAS bf16*)(lds + O_V); LAS bf16* P = (LAS bf16*)(lds + O_P);
    LAS float* DKs = (LAS float*)(lds + O_DK); LAS float* TOT = (LAS float*)(lds + O_TOT);
    const int kc = tid & 127, tq = tid >> 7;
    float c16[16];
    { float run = 0.f;
#pragma unroll
      for (int i = 0; i < 16; ++i) { run += pg8::bflo(pf.la[i]); c16[i] = run; }
      TOT[tq * 128 + kc] = run; }
    if (m0n >= 0) prefetch_la(pf, LAg, m0n, h, tid);
    LDS_WAIT(); __builtin_amdgcn_s_barrier(); asm volatile("" ::: "memory");
    { const float t0 = TOT[kc], t1 = TOT[128 + kc], t2 = TOT[256 + kc], t3 = TOT[384 + kc];
      const float off = tq == 0 ? 0.f : (tq == 1 ? t0 : (tq == 2 ? t0 + t1 : t0 + t1 + t2));
      if (tq == 0) dsum += (t0 + t1) + (t2 + t3);
#pragma unroll
      for (int i = 0; i < 16; ++i) Bm[(16 * tq + i) * 128 + kc] = off + c16[i]; }
#pragma unroll
    for (int j = 0; j < 4; ++j) *(LAS v4u*)(Vs + ((tid >> 5) + 16 * j) * VP + (tid & 31) * 8) = pf.v[j];
    if (m0n >= 0) prefetch_v(pf, Vg, m0n, h, tid);
    LDS_WAIT(); __builtin_amdgcn_s_barrier(); asm volatile("" ::: "memory");
    { const int kblk = (tid & 15) * 8, b16 = kblk & ~15, p0 = b16 + ((kblk & 8) ? 4 : 0), p1 = b16 + ((kblk & 8) ? 12 : 8);
#pragma unroll
      for (int i = 0; i < 2; ++i) { const int t = (tid >> 4) + 32 * i;
        const f32x4 b0 = *(const LAS f32x4*)(Bm + t * 128 + kblk), b1 = *(const LAS f32x4*)(Bm + t * 128 + kblk + 4);
        float e[8], r[8];
#pragma unroll
        for (int j = 0; j < 4; ++j) { e[j] = __expf(b0[j]); e[4 + j] = __expf(b1[j]); }
#pragma unroll
        for (int j = 0; j < 8; ++j) r[j] = __builtin_amdgcn_rcpf(e[j]);
        const v4u kw = pf.k[i];
        const float k0 = pg8::bflo(kw.x) * r[0], k1 = pg8::bfhi(kw.x) * r[1], k2 = pg8::bflo(kw.y) * r[2], k3 = pg8::bfhi(kw.y) * r[3];
        const float k4 = pg8::bflo(kw.z) * r[4], k5 = pg8::bfhi(kw.z) * r[5], k6 = pg8::bflo(kw.w) * r[6], k7 = pg8::bfhi(kw.w) * r[7];
        const unsigned w0 = pk2h(k0, k1), w1 = pk2h(k2, k3), w2 = pk2h(k4, k5), w3 = pk2h(k6, k7);
        *(LAS v4u*)(KX + t * XP + kblk) = (v4u){w0, w1, w2, w3};
        if (WANT_O) {
            *(LAS v2u*)(KI + t * QP + p0) = (v2u){w0, w1}; *(LAS v2u*)(KI + t * QP + p1) = (v2u){w2, w3};
            const v4u qw = pf.q[i];
            const unsigned q0 = pk2h(pg8::bflo(qw.x) * e[0], pg8::bfhi(qw.x) * e[1]), q1 = pk2h(pg8::bflo(qw.y) * e[2], pg8::bfhi(qw.y) * e[3]);
            const unsigned q2 = pk2h(pg8::bflo(qw.z) * e[4], pg8::bfhi(qw.z) * e[5]), q3 = pk2h(pg8::bflo(qw.w) * e[6], pg8::bfhi(qw.w) * e[7]);
            *(LAS v2u*)(QE + t * QP + p0) = (v2u){q0, q1}; *(LAS v2u*)(QE + t * QP + p1) = (v2u){q2, q3};
        } }
      if (tid < 16) { const f32x4 l0 = *(const LAS f32x4*)(Bm + 63 * 128 + 8 * tid), l1 = *(const LAS f32x4*)(Bm + 63 * 128 + 8 * tid + 4);
        *(LAS f32x4*)(DKs + 8 * tid) = (f32x4){__expf(l0[0]), __expf(l0[1]), __expf(l0[2]), __expf(l0[3])};
        *(LAS f32x4*)(DKs + 8 * tid + 4) = (f32x4){__expf(l1[0]), __expf(l1[1]), __expf(l1[2]), __expf(l1[3])}; } }
    if (m0n >= 0) prefetch_kq<WANT_O>(pf, Qg, Kg, m0n, h, tid);
    LDS_WAIT(); __builtin_amdgcn_s_barrier(); asm volatile("" ::: "memory");
    int lane = lane_in; asm volatile("" : "+v"(lane));
    const int fr = lane & 15, fq = lane >> 4, r = lane & 31, hh = lane >> 5, v0 = 32 * wid;
    const int trq = (lane & 15) >> 2, trp = lane & 3, blk = (lane >> 4) & 1;
    v4u sw[4];
    const size_t gbase = (size_t)(m0 + (tid >> 3)) * GVAL + h * DVH + (tid & 7) * 8;
    if (WANT_O) {
#pragma unroll
        for (int j = 0; j < 4; ++j) sw[j] = *(const GAS v4u*)(SRg + gbase + 64 * j);
    }
    if (WANT_O) {
#pragma unroll
        for (int rep = 0; rep < 2; ++rep) {
            const int idx = wid + 8 * rep;
            if (idx < 10) {
                const int ti = idx >= 6 ? 3 : (idx >= 3 ? 2 : (idx >= 1 ? 1 : 0)), si = idx - (ti * (ti + 1)) / 2;
                pg8::f32x4 acc = (pg8::f32x4){0.f, 0.f, 0.f, 0.f};
#pragma unroll
                for (int ks = 0; ks < 4; ++ks) {
                    const bf16x8 a = *(const LAS bf16x8*)(QE + (16 * ti + fr) * QP + 32 * ks + 8 * fq);
                    const bf16x8 b = *(const LAS bf16x8*)(KI + (16 * si + fr) * QP + 32 * ks + 8 * fq);
                    acc = __builtin_amdgcn_mfma_f32_16x16x32_bf16(a, b, acc, 0, 0, 0);
                }
                const int s = 16 * si + fr;
#pragma unroll
                for (int rg = 0; rg < 4; ++rg) { const int t = 16 * ti + 4 * fq + rg; P[t * PP + s] = f2bfh(s <= t ? acc[rg] : 0.f); }
            }
        }
        LDS_WAIT(); __builtin_amdgcn_s_barrier(); asm volatile("" ::: "memory");
    }
    bf16x8 vf[4];
    { const LAS unsigned char* vb = (const LAS unsigned char*)Vs + (8 * hh + trq) * (VP * 2) + (v0 + 16 * blk + 4 * trp) * 2;
#pragma unroll
      for (int ks = 0; ks < 4; ++ks) vf[ks] = cat8(tr4(vb + (16 * ks) * (VP * 2)), tr4(vb + (16 * ks + 4) * (VP * 2))); }
    f32x16 o[2];
    if (WANT_O) {
        bf16x8 pa[6], qa[2][2];
        pa[0] = *(const LAS bf16x8*)(P + (r) * PP + 8 * hh); pa[1] = *(const LAS bf16x8*)(P + (r) * PP + 16 + 8 * hh);
#pragma unroll
        for (int ks = 0; ks < 4; ++ks) pa[2 + ks] = *(const LAS bf16x8*)(P + (32 + r) * PP + 16 * ks + 8 * hh);
#pragma unroll
        for (int s2 = 0; s2 < 2; ++s2)
#pragma unroll
            for (int tt = 0; tt < 2; ++tt) qa[s2][tt] = *(const LAS bf16x8*)(QE + (32 * tt + r) * QP + 16 * s2 + 8 * hh);
#pragma unroll
        for (int tt = 0; tt < 2; ++tt)
#pragma unroll
            for (int j = 0; j < 16; ++j) o[tt][j] = 0.f;
        o[0] = __builtin_amdgcn_mfma_f32_32x32x16_bf16(pa[0], vf[0], o[0], 0, 0, 0);
        o[1] = __builtin_amdgcn_mfma_f32_32x32x16_bf16(pa[2], vf[0], o[1], 0, 0, 0);
        o[0] = __builtin_amdgcn_mfma_f32_32x32x16_bf16(pa[1], vf[1], o[0], 0, 0, 0);
        o[1] = __builtin_amdgcn_mfma_f32_32x32x16_bf16(pa[3], vf[1], o[1], 0, 0, 0);
        o[1] = __builtin_amdgcn_mfma_f32_32x32x16_bf16(pa[4], vf[2], o[1], 0, 0, 0);
        o[1] = __builtin_amdgcn_mfma_f32_32x32x16_bf16(pa[5], vf[3], o[1], 0, 0, 0);
#pragma unroll
        for (int kt = 0; kt < 4; ++kt) {
            bf16x8 qn[2][2];
            if (kt < 3) {
#pragma unroll
                for (int s2 = 0; s2 < 2; ++s2)
#pragma unroll
                    for (int tt = 0; tt < 2; ++tt) qn[s2][tt] = *(const LAS bf16x8*)(QE + (32 * tt + r) * QP + 32 * (kt + 1) + 16 * s2 + 8 * hh);
            }
#pragma unroll
            for (int s2 = 0; s2 < 2; ++s2) {
                v4u bw; bw.x = pk2h(S[kt][8 * s2 + 0], S[kt][8 * s2 + 1]); bw.y = pk2h(S[kt][8 * s2 + 2], S[kt][8 * s2 + 3]);
                bw.z = pk2h(S[kt][8 * s2 + 4], S[kt][8 * s2 + 5]); bw.w = pk2h(S[kt][8 * s2 + 6], S[kt][8 * s2 + 7]);
                const bf16x8 bfr = __builtin_bit_cast(bf16x8, bw);
                o[0] = __builtin_amdgcn_mfma_f32_32x32x16_bf16(qa[s2][0], bfr, o[0], 0, 0, 0);
                o[1] = __builtin_amdgcn_mfma_f32_32x32x16_bf16(qa[s2][1], bfr, o[1], 0, 0, 0);
            }
            if (kt < 3) {
#pragma unroll
                for (int s2 = 0; s2 < 2; ++s2)
#pragma unroll
                    for (int tt = 0; tt < 2; ++tt) qa[s2][tt] = qn[s2][tt];
            }
        }
#pragma unroll
        for (int tt = 0; tt < 2; ++tt)
#pragma unroll
            for (int j = 0; j < 16; ++j) OT[(32 * tt + (j & 3) + 8 * (j >> 2) + 4 * hh) * OP + v0 + r] = f2bfh(o[tt][j]);
    }
    { const LAS unsigned char* kb = (const LAS unsigned char*)KX + (8 * hh + trq) * (XP * 2) + (16 * blk + 4 * trp) * 2;
#pragma unroll
      for (int kp = 0; kp < 2; ++kp) {
        bf16x8 ka[2][4];
#pragma unroll
        for (int q2 = 0; q2 < 2; ++q2)
#pragma unroll
            for (int ks = 0; ks < 4; ++ks) ka[q2][ks] = cat8(tr4(kb + (16 * ks) * (XP * 2) + 64 * (2 * kp + q2)), tr4(kb + (16 * ks + 4) * (XP * 2) + 64 * (2 * kp + q2)));
#pragma unroll
        for (int ks = 0; ks < 4; ++ks) {
            S[2 * kp] = __builtin_amdgcn_mfma_f32_32x32x16_bf16(ka[0][ks], vf[ks], S[2 * kp], 0, 0, 0);
            S[2 * kp + 1] = __builtin_amdgcn_mfma_f32_32x32x16_bf16(ka[1][ks], vf[ks], S[2 * kp + 1], 0, 0, 0);
        }
#pragma unroll
        for (int q2 = 0; q2 < 2; ++q2)
#pragma unroll
            for (int g4 = 0; g4 < 4; ++g4) { const f32x4 d4 = *(const LAS f32x4*)(DKs + 32 * (2 * kp + q2) + 8 * g4 + 4 * hh);
#pragma unroll
                for (int e = 0; e < 4; ++e) S[2 * kp + q2][4 * g4 + e] *= d4[e]; }
      } }
    if (WANT_O) {
        LDS_WAIT(); __builtin_amdgcn_s_barrier(); asm volatile("" ::: "memory");
        int te = tid; asm volatile("" : "+v"(te));
        const int t = te >> 3, part = te & 7;
        const size_t gbase2 = (size_t)(m0 + t) * GVAL + h * DVH + part * 8;
        v4u ow[4]; float q = 0.f;
#pragma unroll
        for (int j = 0; j < 4; ++j) ow[j] = *(const LAS v4u*)(OT + t * OP + part * 8 + 64 * j);
#pragma unroll
        for (int j = 0; j < 4; ++j) { const float a0 = pg8::bflo(ow[j].x), a1 = pg8::bfhi(ow[j].x), a2 = pg8::bflo(ow[j].y), a3 = pg8::bfhi(ow[j].y), a4 = pg8::bflo(ow[j].z), a5 = pg8::bfhi(ow[j].z), a6 = pg8::bflo(ow[j].w), a7 = pg8::bfhi(ow[j].w);
            q += (a0 * a0 + a1 * a1) + (a2 * a2 + a3 * a3) + (a4 * a4 + a5 * a5) + (a6 * a6 + a7 * a7); }
        q += __shfl_xor(q, 1); q += __shfl_xor(q, 2); q += __shfl_xor(q, 4);
        const float rs = 1.0f / sqrtf(q * (1.f / 256.f) + EPS);
#pragma unroll
        for (int j = 0; j < 4; ++j) {
            v4u w;
            w.x = pk2h(pg8::bflo(ow[j].x) * rs * pg8::bflo(sw[j].x), pg8::bfhi(ow[j].x) * rs * pg8::bfhi(sw[j].x));
            w.y = pk2h(pg8::bflo(ow[j].y) * rs * pg8::bflo(sw[j].y), pg8::bfhi(ow[j].y) * rs * pg8::bfhi(sw[j].y));
            w.z = pk2h(pg8::bflo(ow[j].z) * rs * pg8::bflo(sw[j].z), pg8::bfhi(ow[j].z) * rs * pg8::bfhi(sw[j].z));
            w.w = pk2h(pg8::bflo(ow[j].w) * rs * pg8::bflo(sw[j].w), pg8::bfhi(ow[j].w) * rs * pg8::bfhi(sw[j].w));
            *(GAS v4u*)(OG + gbase2 + 64 * j) = w; }
    }
}

__device__ __forceinline__ void meta_state(LAS unsigned char* lds, const float* KM, const float* VM, const float* AL, const float* wgu, const float* bgate, int h, f32x16 (&S)[4], int tid, int wid, int lane) {
    LAS float* LM = (LAS float*)lds;
    LAS float* KS = (LAS float*)(lds + 8192);
    const int kc = tid & 127, part = tid >> 7;
#pragma unroll
    for (int i = 0; i < 4; ++i) { const int s = 4 * part + i; float z = bgate[h * DKH + kc];
#pragma unroll
        for (int rr = 0; rr < RANK; ++rr) z += AL[s * RANK + rr] * wgu[rr * GKEY + h * DKH + kc];
        LM[s * 128 + kc] = pg8::logsigf_(z) * 0.0625f; }
    LDS_WAIT(); __syncthreads();
    if (part == 0) { float km[16], lm[16];
#pragma unroll
        for (int s = 0; s < 16; ++s) { km[s] = KM[s * GKEY + h * DKH + kc]; lm[s] = LM[s * 128 + kc]; }
        float suf = 0.f;
#pragma unroll
        for (int s = 15; s >= 0; --s) { KS[s * 128 + kc] = km[s] * __expf(suf); suf += lm[s]; } }
    LDS_WAIT(); __syncthreads();
    const int r = lane & 31, hh = lane >> 5, v0 = 32 * wid;
    float vm[16];
#pragma unroll
    for (int s = 0; s < 16; ++s) vm[s] = VM[s * GVAL + h * DVH + v0 + r];
#pragma unroll
    for (int kt = 0; kt < 4; ++kt)
#pragma unroll
        for (int g4 = 0; g4 < 4; ++g4) { f32x4 a = (f32x4){0.f, 0.f, 0.f, 0.f};
#pragma unroll
            for (int s = 0; s < 16; ++s) a += *(const LAS f32x4*)(KS + s * 128 + 32 * kt + 8 * g4 + 4 * hh) * vm[s];
#pragma unroll
            for (int e = 0; e < 4; ++e) S[kt][4 * g4 + e] = a[e]; }
    LDS_WAIT(); __syncthreads();
}
}

__global__ void __launch_bounds__(NWAVES * 64, 2) fwd_kernel(Args args) {
    extern __shared__ __attribute__((aligned(16))) unsigned char lds_raw[];
    LAS unsigned char* lds = (LAS unsigned char*)lds_raw;
    volatile LAS unsigned* MISC = (volatile LAS unsigned*)(lds + MISC_OFF);
    const int G = gridDim.x; const int bx = blockIdx.x; const int vcu = (G % 8 == 0) ? (bx % 8) * (G / 8) + bx / 8 : bx;
    const int wave = __builtin_amdgcn_readfirstlane((int)threadIdx.x >> 6);
#define LANE_ID() ((int)__builtin_amdgcn_mbcnt_hi(~0u, __builtin_amdgcn_mbcnt_lo(~0u, 0u)))
#define T0() (wave == 0 && LANE_ID() == 0)
#define PHASE_IDS() int lane_ = LANE_ID(); asm volatile("" : "+v"(lane_)); const int lane = lane_, tid = wave * 64 + lane; const int gw = vcu * NWAVES + wave, NGW = G * NWAVES; (void)tid; (void)gw; (void)NGW
    unsigned char* ws = args.ws;
    unsigned* ctl = (unsigned*)(ws + WS_CTL);
#define INP(i) (args.in[launder_idx(i)])
#define x_in INP(0)
#define meta_tokens INP(1)
#define g_mix_pre INP(2)
#define w_in INP(3)
#define w_gate_up INP(4)
#define b_gate INP(5)
#define gla_norm_g INP(6)
#define w_o_gla INP(7)
#define a_re INP(8)
#define a_im INP(9)
#define log_step INP(10)
#define b_re INP(11)
#define b_im INP(12)
#define c_re INP(13)
#define c_im INP(14)
#define d_skip INP(15)
#define w_glu INP(16)
#define b_glu INP(17)
#define w_out INP(18)
#define g_mix_post INP(19)
#define g_ffn_pre INP(20)
#define w_ff1 INP(21)
#define w_ff2 INP(22)
#define g_ffn_post INP(23)
    float* out = args.out;
    bf16* WT_in = (bf16*)(ws + WS_WIN); bf16* WT_o = (bf16*)(ws + WS_WO); bf16* WT_glu = (bf16*)(ws + WS_WGLU); bf16* WT_out = (bf16*)(ws + WS_WOUT);
    bf16* WT_ff1 = (bf16*)(ws + WS_WFF1); bf16* WT_ff2 = (bf16*)(ws + WS_WFF2); bf16* TZ = (bf16*)(ws + WS_TZ); bf16* MS = (bf16*)(ws + WS_MS);
    bf16* XN = (bf16*)(ws + WS_XN); bf16* OG = XN; bf16* HN = XN;
    bf16* Qb = (bf16*)(ws + WS_Q); bf16* Kb = (bf16*)(ws + WS_K); bf16* Vb = (bf16*)(ws + WS_V); bf16* SR = (bf16*)(ws + WS_SR); bf16* LAb = (bf16*)(ws + WS_LA); bf16* UH = (bf16*)(ws + WS_UH);
    bf16* GS = (bf16*)(ws + WS_GS); bf16* YG = (bf16*)(ws + WS_YG); bf16* MIX = (bf16*)(ws + WS_MIX); float* T1 = (float*)(ws + WS_T);
    bf16* F1 = (bf16*)(ws + WS_F1); float* T2 = (float*)(ws + WS_T2);
    bf16* SZG = (bf16*)out; bf16* SZS = (bf16*)out + (size_t)M * D;
    float* KM = (float*)(ws + WS_SMALL + SM_KM); float* VM = (float*)(ws + WS_SMALL + SM_VM); float* AL = (float*)(ws + WS_SMALL + SM_AL);
    float* UM = (float*)(ws + WS_SMALL + SM_UM); float* L16 = (float*)(ws + WS_SMALL + SM_L16);
    float* HM = (float*)(ws + WS_SMALL + SM_HM);
    float* DS = (float*)(ws + WS_DS); float* DD = (float*)(ws + WS_DS + 32 * MiB);

    for (int u = wave * 64 + LANE_ID(); u < (LDS_BYTES - LDSCTL_OFF) / 4; u += NWAVES * 64) ((LAS unsigned*)(lds + LDSCTL_OFF))[u] = 0u;
    __syncthreads();
    XcdBarrier bar; bar.bar = ctl + CW_BAR; bar.x = 0; bar.st = nullptr;
    if (N_LAUNCHES == 1) bar = xcd_barrier_post(ctl + CW_BAR, MISC + 8, T0());
    const int lo = args.ph_lo, hi = args.ph_hi;
#define IN(k) (lo <= (k) && (k) < hi)
#define SEAM(k) do { if (IN(k) && IN((k) + 1)) xcd_barrier(bar, T0()); } while (0)

    if (IN(0)) for (int rep_ = 0; rep_ <= ((PROBE_REP_MASK >> 0) & 1); ++rep_) {
        PHASE_IDS();
        if (vcu < 41) {
            const float* meta_p = meta_tokens; const float* gpre_p = g_mix_pre; const float* w_in_p = w_in;
            LAS float* XNM = (LAS float*)lds;
            LAS float* PART = (LAS float*)(lds + 65536);
#pragma unroll
            for (int rr = 0; rr < 2; ++rr) { const int row = 2 * wave + rr;
                const GAS f32x4* xr = (const GAS f32x4*)(meta_p + (size_t)row * D) + lane; const GAS f32x4* gr = (const GAS f32x4*)gpre_p + lane;
                f32x4 v[4]; float s = 0.f;
#pragma unroll
                for (int j = 0; j < 4; ++j) { v[j] = xr[64 * j]; s += (v[j].x * v[j].x + v[j].y * v[j].y) + (v[j].z * v[j].z + v[j].w * v[j].w); }
                const float rs = 1.0f / sqrtf(wave_sum(s) * (1.f / 1024.f) + EPS);
#pragma unroll
                for (int j = 0; j < 4; ++j) { const f32x4 g = gr[64 * j]; *(LAS f32x4*)(XNM + row * 1024 + 4 * lane + 256 * j) = (f32x4){v[j].x * rs * g.x, v[j].y * rs * g.y, v[j].z * rs * g.z, v[j].w * rs * g.w}; } }
            LDS_WAIT(); __syncthreads();
            const int it = vcu; int src, ncol; float* dst; int dld, dcol;
            if (it < 8)       { src = 512 + 64 * it;          ncol = 64; dst = KM; dld = 512;  dcol = 64 * it; }
            else if (it < 24) { src = 1024 + 64 * (it - 8);   ncol = 64; dst = VM; dld = 1024; dcol = 64 * (it - 8); }
            else if (it == 24){ src = SRC_A;                  ncol = 16; dst = AL; dld = 16;   dcol = 0; }
            else              { src = SRC_U + 64 * (it - 25); ncol = 64; dst = UM; dld = 1024; dcol = 64 * (it - 25); }
            float acc[16];
#pragma unroll
            for (int rr = 0; rr < 16; ++rr) acc[rr] = 0.f;
            const bool colok = lane < ncol;
            for (int k4 = 0; k4 < 32; ++k4) { const int k = 128 * wave + 4 * k4;
                float wv[4];
#pragma unroll
                for (int e = 0; e < 4; ++e) wv[e] = colok ? w_in_p[(size_t)(k + e) * IN_W + src + lane] : 0.f;
#pragma unroll
                for (int rr = 0; rr < 16; ++rr) { const f32x4 xv = *(const LAS f32x4*)(XNM + rr * 1024 + k); acc[rr] += (xv.x * wv[0] + xv.y * wv[1]) + (xv.z * wv[2] + xv.w * wv[3]); } }
#pragma unroll
            for (int rr = 0; rr < 16; ++rr) PART[(wave * 16 + rr) * 64 + lane] = acc[rr];
            LDS_WAIT(); __syncthreads();
#pragma unroll
            for (int e = 0; e < 2; ++e) { const int idx = tid + 512 * e, rr = idx >> 6, col = idx & 63; float s = 0.f;
#pragma unroll
                for (int w = 0; w < 8; ++w) s += PART[(w * 16 + rr) * 64 + col];
                if (col < ncol) dst[rr * dld + dcol + col] = s; }
            LDS_WAIT(); __syncthreads();
        }
        LAS float* scr = (LAS float*)(lds + wave * 17408);
        constexpr int I_IN = 192 * 16, I_O = 32 * 16, I_GLU = 64 * 16, I_OUT = 32 * 16, I_FF1 = 128 * 16, I_FF2 = 32 * 64;
        constexpr int I_WA = 8 * 128, I_SSM = 64 * 16, I_T = I_IN + I_O + I_GLU + I_OUT + I_FF1 + I_FF2;
        if (gw < I_SSM) {
            const float* a_re_p = a_re; const float* a_im_p = a_im; const float* ls_p = log_step; const float* b_re_p = b_re; const float* b_im_p = b_im;
            const float* c_re_p = c_re; const float* c_im_p = c_im; const float* dsk_p = d_skip;
            const int g = gw >> 4, d = gw & 15, n = lane;
            LAS float* BBr = scr;
            LAS float* BBi = scr + 1024;
            LAS float* CWr = scr + 2048;
            LAS float* CWi = scr + 2048 + 1040;
            const float ar = a_re_p[g * SN + n], ai = a_im_p[g * SN + n], dt = expf(ls_p[g]);
            const float mag = expf(ar * dt), lr = mag * cosf(ai * dt), li = mag * sinf(ai * dt);
            const float zr = lr - 1.0f, zi = li, den = ar * ar + ai * ai, fre = (zr * ar + zi * ai) / den, fim = (zi * ar - zr * ai) / den;
            float bbr[16], bbi[16];
            { f32x4 br4[4], bi4[4];
#pragma unroll
              for (int q = 0; q < 4; ++q) { br4[q] = *(const GAS f32x4*)(b_re_p + (g * SN + n) * SHG + 4 * q); bi4[q] = *(const GAS f32x4*)(b_im_p + (g * SN + n) * SHG + 4 * q); }
#pragma unroll
              for (int j = 0; j < 16; ++j) { const float br = br4[j >> 2][j & 3], bi = bi4[j >> 2][j & 3];
                bbr[j] = fre * br - fim * bi; bbi[j] = fre * bi + fim * br; BBr[n * 16 + j] = bbr[j]; BBi[n * 16 + j] = bbi[j]; } }
            auto powl = [&](int pw) { const float mg = expf((float)pw * (ar * dt)), an = (float)pw * (ai * dt); return cpx{mg * cosf(an), mg * sinf(an)}; };
            const cpx wd = powl(d), wd1 = powl(d + 1), w15 = powl(15 - d);
            float cr16[16], ci16[16];
#pragma unroll
            for (int i = 0; i < 16; ++i) { cr16[i] = c_re_p[(g * SHG + i) * SN + n]; ci16[i] = c_im_p[(g * SHG + i) * SN + n]; }
#pragma unroll
            for (int i = 0; i < 16; ++i) { const cpx cw = cmul(cpx{cr16[i], ci16[i]}, wd); CWr[i * 65 + n] = cw.r; CWi[i * 65 + n] = cw.i; }
            LDS_WAIT(); asm volatile("" ::: "memory");
            {
                const int i = lane >> 2, j0 = (lane & 3) * 4; float a4[4] = {0.f, 0.f, 0.f, 0.f};
#pragma unroll 8
                for (int nn = 0; nn < SN; ++nn) { const float cwr = CWr[i * 65 + nn], cwi = CWi[i * 65 + nn];
                    const f32x4 br = *(const LAS f32x4*)(BBr + nn * 16 + j0), bi = *(const LAS f32x4*)(BBi + nn * 16 + j0);
#pragma unroll
                    for (int e = 0; e < 4; ++e) a4[e] += cwr * br[e] - cwi * bi[e]; }
                if (d == 0) {
#pragma unroll
                    for (int e = 0; e < 4; ++e) if (i == j0 + e) a4[e] += dsk_p[g * SHG + i]; }
                const v2u val = (v2u){pk2(a4[0], a4[1]), pk2(a4[2], a4[3])}, zero = (v2u){0u, 0u};
                for (int t = d; t < 16; ++t) *(GAS v2u*)(TZ + (size_t)(g * 256 + 16 * t + i) * 384 + 16 * (t - d) + j0) = val;
                if (d >= 1) for (int t = 0; t + d < 16; ++t) *(GAS v2u*)(TZ + (size_t)(g * 256 + 16 * t + i) * 384 + 16 * (t + d) + j0) = zero;
            }
#pragma unroll
            for (int i = 0; i < 16; ++i) { const cpx cl = cmul(cpx{cr16[i], ci16[i]}, wd1);
                TZ[(size_t)(g * 256 + 16 * d + i) * 384 + 256 + n] = (bf16)f2bf(cl.r); TZ[(size_t)(g * 256 + 16 * d + i) * 384 + 320 + n] = (bf16)f2bf(-cl.i); }
            { unsigned pr[8], pi[8];
#pragma unroll
                for (int j = 0; j < 16; j += 2) { const cpx v0 = cmul(w15, cpx{bbr[j], bbi[j]}), v1 = cmul(w15, cpx{bbr[j + 1], bbi[j + 1]}); pr[j >> 1] = pk2(v0.r, v1.r); pi[j >> 1] = pk2(v0.i, v1.i); }
                GAS v4u* p0 = (GAS v4u*)(MS + (size_t)(g * 128 + n) * 256 + 16 * d); p0[0] = (v4u){pr[0], pr[1], pr[2], pr[3]}; p0[1] = (v4u){pr[4], pr[5], pr[6], pr[7]};
                GAS v4u* p1 = (GAS v4u*)(MS + (size_t)(g * 128 + 64 + n) * 256 + 16 * d); p1[0] = (v4u){pi[0], pi[1], pi[2], pi[3]}; p1[1] = (v4u){pi[4], pi[5], pi[6], pi[7]}; }
            if (d == 0) { const cpx w16 = powl(16); L16[(g * SN + n) * 2] = w16.r; L16[(g * SN + n) * 2 + 1] = w16.i; }
            LDS_WAIT(); asm volatile("" ::: "memory");
        }
        if (gw >= NGW - I_WA) {
            const float* w_in_p = w_in; const float* wgu_p = w_gate_up;
            const int r = gw - (NGW - I_WA), nb = r >> 7, kb = r & 127, n = 64 * nb + lane;
            float wg[16];
#pragma unroll
            for (int rr = 0; rr < 16; ++rr) wg[rr] = wgu_p[rr * GKEY + n];
            float o8[8];
#pragma unroll
            for (int e = 0; e < 8; ++e) { const float* wr_ = w_in_p + (size_t)(8 * kb + e) * IN_W + SRC_A; float sacc = 0.f;
#pragma unroll
                for (int rr = 0; rr < 16; ++rr) sacc += wr_[rr] * wg[rr];
                o8[e] = sacc; }
            *(GAS v4u*)(WT_in + (size_t)(6144 + n) * D + 8 * kb) = (v4u){pk2(o8[0], o8[1]), pk2(o8[2], o8[3]), pk2(o8[4], o8[5]), pk2(o8[6], o8[7])};
        }
        {
            const float* w_in_p = w_in; const float* w_o_p = w_o_gla; const float* w_glu_p = w_glu; const float* w_out_p = w_out; const float* w_ff1_p = w_ff1; const float* w_ff2_p = w_ff2; const float* gn_p0 = gla_norm_g;
            for (int it = gw; it < I_T; it += NGW) {
                int r = it;
                if (r < I_IN) { const int rb = r >> 4, kb = r & 15, d0 = 32 * rb; p0_transpose_item(w_in_p, IN_W, d0 < 3072 ? d0 : d0 + 16, D, WT_in, d0, scr, kb, lane); continue; } r -= I_IN;
                if (r < I_O) { const int rb = r >> 4, kb = r & 15; p0_transpose_item(w_o_p, D, 32 * rb, GVAL, WT_o, 32 * rb, scr, kb, lane, gn_p0); continue; } r -= I_O;
                if (r < I_GLU) { const int rb = r >> 4, kb = r & 15, d0 = 32 * rb, pn = d0 >> 8, wi = d0 & 255;
                    p0_transpose_item(w_glu_p, 2 * D, wi < 128 ? 128 * pn + wi : 1024 + 128 * pn + (wi - 128), D, WT_glu, d0, scr, kb, lane); continue; } r -= I_GLU;
                if (r < I_OUT) { const int rb = r >> 4, kb = r & 15; p0_transpose_item(w_out_p, D, 32 * rb, D, WT_out, 32 * rb, scr, kb, lane); continue; } r -= I_OUT;
                if (r < I_FF1) { const int rb = r >> 4, kb = r & 15; p0_transpose_item(w_ff1_p, FF, 32 * rb, D, WT_ff1, 32 * rb, scr, kb, lane); continue; } r -= I_FF1;
                { const int rb = r >> 6, kb = r & 63; p0_transpose_item(w_ff2_p, D, 32 * rb, FF, WT_ff2, 32 * rb, scr, kb, lane); }
            }
        }
        {
            const float* xp = x_in; const float* gp = g_mix_pre;
            const GAS f32x4* gr = (const GAS f32x4*)gp + lane;
            f32x4 gv[4];
#pragma unroll
            for (int j = 0; j < 4; ++j) gv[j] = gr[64 * j];
            const int gw2 = (vcu - 41) * NWAVES + wave, NGW2 = (G - 41) * NWAVES;
            if (vcu >= 41)
            for (int m = gw2; m < M; m += 2 * NGW2) {
                const int m2 = (m + NGW2 < M) ? m + NGW2 : m;
                const GAS f32x4* xa = (const GAS f32x4*)(xp + (size_t)m * D) + lane; const GAS f32x4* xb = (const GAS f32x4*)(xp + (size_t)m2 * D) + lane;
                f32x4 va[4], vb[4]; float sa = 0.f, sb = 0.f;
#pragma unroll
                for (int j = 0; j < 4; ++j) { va[j] = xa[64 * j]; vb[j] = xb[64 * j]; }
#pragma unroll
                for (int j = 0; j < 4; ++j) { sa += (va[j].x * va[j].x + va[j].y * va[j].y) + (va[j].z * va[j].z + va[j].w * va[j].w); sb += (vb[j].x * vb[j].x + vb[j].y * vb[j].y) + (vb[j].z * vb[j].z + vb[j].w * vb[j].w); }
                const float ra = 1.0f / sqrtf(wave_sum(sa) * (1.f / 1024.f) + EPS), rb = 1.0f / sqrtf(wave_sum(sb) * (1.f / 1024.f) + EPS);
                GAS unsigned long long* oa = (GAS unsigned long long*)(XN + (size_t)m * D) + lane; GAS unsigned long long* ob = (GAS unsigned long long*)(XN + (size_t)m2 * D) + lane;
#pragma unroll
                for (int j = 0; j < 4; ++j) {
                    oa[64 * j] = (unsigned long long)pk2(va[j].x * ra * gv[j].x, va[j].y * ra * gv[j].y) | ((unsigned long long)pk2(va[j].z * ra * gv[j].z, va[j].w * ra * gv[j].w) << 32);
                    ob[64 * j] = (unsigned long long)pk2(vb[j].x * rb * gv[j].x, vb[j].y * rb * gv[j].y) | ((unsigned long long)pk2(vb[j].z * rb * gv[j].z, vb[j].w * rb * gv[j].w) << 32); }
            }
        }
    }
    SEAM(0);

    if (IN(1)) for (int rep_ = 0; rep_ <= ((PROBE_REP_MASK >> 1) & 1); ++rep_) {
        pg8::Gemm g{XN, WT_in, D, D, D, 256}; pg8::StaticOrder S; S.init(M, NIN, G, bx);
        pg8::EpiIn E{Qb, Kb, Vb, SR, UH, SZG, SZS, LAb, b_gate};
        pg8::gemm_phase<pg8::EpiIn, pg8::StaticOrder, true>(lds, g, S, E, wave);
    }
    SEAM(1);

    if (IN(2)) {
        for (int rep_ = 0; rep_ <= ((PROBE_REP_MASK >> 2) & 1); ++rep_)
        { pg8::Gemm g{UH, MS, 384, 256, 256, 128}; pg8::GroupOrder S{G, bx};
          pg8::EpiE E{UH};
          pg8::gemm_phase<pg8::EpiE, pg8::GroupOrder, true>(lds, g, S, E, wave); }
        for (int rep_ = 0; rep_ <= ((PROBE_REP_MASK >> 11) & 1); ++rep_)
        { PHASE_IDS();
          const int u = vcu & 255, bh = u >> 3, seg = u & 7;
            if (seg < 7) {
                const int b = bh >> 2, h = bh & 3, mf = b * SEQ + seg * 512;
                f32x16 S[4];
#pragma unroll
                for (int kt = 0; kt < 4; ++kt)
#pragma unroll
                    for (int j = 0; j < 16; ++j) S[kt][j] = 0.f;
                float dsum = 0.f; gla::Pref pf;
                gla::prefetch<false>(pf, Qb, Kb, LAb, Vb, mf, h, tid);
                for (int c = 0; c < 8; ++c)
                    gla::chunk<false>(lds, Qb, Kb, LAb, Vb, SR, nullptr, OG, mf + 64 * c, c < 7 ? mf + 64 * (c + 1) : -1, h, S, pf, dsum, tid, wave, lane);
                float* ds = DS + (size_t)(bh * 7 + seg) * (16 * 2048);
#pragma unroll
                for (int kt = 0; kt < 4; ++kt)
#pragma unroll
                    for (int g4 = 0; g4 < 4; ++g4) *(GAS f32x4*)(ds + ((kt * 4 + g4) * 512 + tid) * 4) = (f32x4){S[kt][4 * g4], S[kt][4 * g4 + 1], S[kt][4 * g4 + 2], S[kt][4 * g4 + 3]};
                if (tid < 128) DD[(bh * 7 + seg) * 128 + tid] = dsum;
            } else if (wave < 2) {
                const int g = 2 * bh + wave, n = lane; float hr = 0.f, hi_ = 0.f;
                const bf16* m0p = MS + (size_t)(g * 128 + n) * 256; const bf16* m1p = MS + (size_t)(g * 128 + 64 + n) * 256;
                for (int kb = 0; kb < 32; ++kb) { const v4u a = *(const GAS v4u*)(m0p + 8 * kb), c4 = *(const GAS v4u*)(m1p + 8 * kb);
                    const float* up = UM + (kb >> 1) * D + g * SHG + (kb & 1) * 8;
                    const f32x4 u0 = *(const GAS f32x4*)up, u1 = *(const GAS f32x4*)(up + 4);
                    hr += (pg8::bflo(a.x) * u0[0] + pg8::bfhi(a.x) * u0[1]) + (pg8::bflo(a.y) * u0[2] + pg8::bfhi(a.y) * u0[3]) + (pg8::bflo(a.z) * u1[0] + pg8::bfhi(a.z) * u1[1]) + (pg8::bflo(a.w) * u1[2] + pg8::bfhi(a.w) * u1[3]);
                    hi_ += (pg8::bflo(c4.x) * u0[0] + pg8::bfhi(c4.x) * u0[1]) + (pg8::bflo(c4.y) * u0[2] + pg8::bfhi(c4.y) * u0[3]) + (pg8::bflo(c4.z) * u1[0] + pg8::bfhi(c4.z) * u1[1]) + (pg8::bflo(c4.w) * u1[2] + pg8::bfhi(c4.w) * u1[3]); }
                HM[g * 128 + n] = hr; HM[g * 128 + 64 + n] = hi_;
            }
        }
        __syncthreads();
    }
    SEAM(2);

    if (IN(3)) {
        for (int rep_ = 0; rep_ <= ((PROBE_REP_MASK >> 10) & 1); ++rep_)
        {
            PHASE_IDS();
            LAS bf16* EL = (LAS bf16*)lds;
#pragma unroll
            for (int pp = 0; pp < 2; ++pp) { const int p = (2 * vcu + pp) & 511, b = p >> 6, g = p & 63; const bf16* src = UH + (size_t)(g * 2048 + b * 256) * 384 + 256;
                v4u tmp[8];
#pragma unroll
                for (int it = 0; it < 8; ++it) { const int idx = tid + 512 * it, c = idx >> 4, pc = idx & 15; tmp[it] = *(const GAS v4u*)(src + (size_t)c * 384 + pc * 8); }
#pragma unroll
                for (int it = 0; it < 8; ++it) { const int idx = tid + 512 * it, c = idx >> 4, pc = idx & 15; *(LAS v4u*)(EL + (pp * 256 + c) * 128 + pc * 8) = tmp[it]; } }
            LDS_WAIT(); __syncthreads();
            if (wave < 2) {
                const int p = (2 * vcu + wave) & 511, g = p & 63, n = lane;
                float hr = HM[g * 128 + n], hi_ = HM[g * 128 + 64 + n];
                const float lr = L16[(g * SN + n) * 2], li = L16[(g * SN + n) * 2 + 1];
                LAS bf16* el = EL + wave * 256 * 128 + n;
#pragma unroll 8
                for (int c = 0; c < 256; ++c) { const float er = bf2f(el[c * 128]), ei = bf2f(el[c * 128 + 64]);
                    el[c * 128] = (bf16)f2bf(hr); el[c * 128 + 64] = (bf16)f2bf(hi_);
                    const float nr = lr * hr - li * hi_ + er, ni = lr * hi_ + li * hr + ei; hr = nr; hi_ = ni; }
            }
            LDS_WAIT(); __syncthreads();
            if (rep_ == ((PROBE_REP_MASK >> 10) & 1))
#pragma unroll
            for (int pp = 0; pp < 2; ++pp) { const int p = (2 * vcu + pp) & 511, b = p >> 6, g = p & 63; bf16* dst = UH + (size_t)(g * 2048 + b * 256) * 384 + 256;
                for (int idx = tid; idx < 256 * 16; idx += 512) { const int c = idx >> 4, pc = idx & 15; *(GAS v4u*)(dst + (size_t)c * 384 + pc * 8) = *(const LAS v4u*)(EL + (pp * 256 + c) * 128 + pc * 8); } }
            LDS_WAIT(); __syncthreads();
        }
        for (int rep_ = 0; rep_ <= ((PROBE_REP_MASK >> 3) & 1); ++rep_)
        { PHASE_IDS();
          const int u = vcu & 255, bh = u >> 3, seg = u & 7, b = bh >> 2, h = bh & 3, mf = b * SEQ + seg * 512;
            for (int i = tid; i < 64 * gla::PP / 2; i += 512) ((LAS unsigned*)(lds + gla::O_P))[i] = 0u;
            f32x16 S[4];
            gla::meta_state(lds, KM, VM, AL, w_gate_up, b_gate, h, S, tid, wave, lane);
            if (seg > 0) {
                LAS float* EDL = (LAS float*)(lds + gla::O_B);
                for (int i = tid; i < seg * 128; i += 512) EDL[i] = __expf(DD[bh * 7 * 128 + i]);
                LDS_WAIT(); __syncthreads();
#pragma unroll 1
                for (int j = 0; j < seg; ++j) {
                    const float* ds = DS + (size_t)(bh * 7 + j) * (16 * 2048) + tid * 4;
                    f32x4 ca[16];
#pragma unroll
                    for (int q = 0; q < 16; ++q) ca[q] = *(const GAS f32x4*)(ds + q * 2048);
#pragma unroll
                    for (int q = 0; q < 16; ++q) { const f32x4 d4 = *(const LAS f32x4*)(EDL + j * 128 + 32 * (q >> 2) + 8 * (q & 3) + 4 * (lane >> 5));
#pragma unroll
                        for (int e = 0; e < 4; ++e) S[q >> 2][4 * (q & 3) + e] = d4[e] * S[q >> 2][4 * (q & 3) + e] + ca[q][e]; }
                }
                __syncthreads();
            }
            float dsum = 0.f; gla::Pref pf; const float* gn_p = gla_norm_g;
            gla::prefetch<true>(pf, Qb, Kb, LAb, Vb, mf, h, tid);
            for (int c = 0; c < 8; ++c)
                gla::chunk<true>(lds, Qb, Kb, LAb, Vb, SR, gn_p, OG, mf + 64 * c, c < 7 ? mf + 64 * (c + 1) : -1, h, S, pf, dsum, tid, wave, lane);
            __syncthreads();
        }
    }
    SEAM(3);

    if (IN(4)) {
        for (int rep_ = 0; rep_ <= ((PROBE_REP_MASK >> 4) & 1); ++rep_)
        { pg8::Gemm g{UH, TZ, 384, 384, 384, 256}; pg8::GroupOrder S{G, bx}; pg8::EpiS E{GS};
          pg8::gemm_phase<pg8::EpiS, pg8::GroupOrder, true>(lds, g, S, E, wave); }
        for (int rep_ = 0; rep_ <= ((PROBE_REP_MASK >> 12) & 1); ++rep_)
        { pg8::Gemm g{OG, WT_o, D, D, D, 256}; pg8::StaticOrder S; S.init(M, D, G, bx); pg8::EpiYG E{SZG, YG};
          pg8::gemm_phase<pg8::EpiYG, pg8::StaticOrder, true>(lds, g, S, E, wave); }
    }
    SEAM(4);

    if (IN(5)) for (int rep_ = 0; rep_ <= ((PROBE_REP_MASK >> 5) & 1); ++rep_) {
        pg8::Gemm g{GS, WT_glu, D, D, D, 256}; pg8::StaticOrder S; S.init(M, 2 * D, G, bx); pg8::EpiGlu E{YG, SZS, MIX, b_glu};
        pg8::gemm_phase<pg8::EpiGlu, pg8::StaticOrder, true, true>(lds, g, S, E, wave);
    }
    SEAM(5);

    if (IN(6)) for (int rep_ = 0; rep_ <= ((PROBE_REP_MASK >> 6) & 1); ++rep_) {
        pg8::Gemm g{MIX, WT_out, D, D, D, 256}; pg8::StaticOrder S; S.init(M, D, G, bx); pg8::EpiF32 E{T1, D};
        pg8::gemm_phase<pg8::EpiF32, pg8::StaticOrder, true>(lds, g, S, E, wave);
    }
    SEAM(6);

    if (IN(7)) for (int rep_ = 0; rep_ <= ((PROBE_REP_MASK >> 7) & 1); ++rep_) {
        PHASE_IDS();
        const float* xp = x_in; const float* gpost_p = g_mix_post; const float* gfpre_p = g_ffn_pre;
        for (int m = gw; m < M; m += NGW) {
            const GAS f32x4* tr = (const GAS f32x4*)(T1 + (size_t)m * D) + lane; const GAS f32x4* xr = (const GAS f32x4*)(xp + (size_t)m * D) + lane;
            const GAS f32x4* g1 = (const GAS f32x4*)gpost_p + lane; const GAS f32x4* g2 = (const GAS f32x4*)gfpre_p + lane;
            f32x4 v[4]; float s = 0.f;
#pragma unroll
            for (int j = 0; j < 4; ++j) { v[j] = tr[64 * j]; s += (v[j].x * v[j].x + v[j].y * v[j].y) + (v[j].z * v[j].z + v[j].w * v[j].w); }
            const float rs = 1.0f / sqrtf(wave_sum(s) * (1.f / 1024.f) + EPS); float s2 = 0.f;
#pragma unroll
            for (int j = 0; j < 4; ++j) { const f32x4 g = g1[64 * j], xv = xr[64 * j]; v[j] = (f32x4){xv.x + v[j].x * rs * g.x, xv.y + v[j].y * rs * g.y, xv.z + v[j].z * rs * g.z, xv.w + v[j].w * rs * g.w};
                s2 += (v[j].x * v[j].x + v[j].y * v[j].y) + (v[j].z * v[j].z + v[j].w * v[j].w);
                *((GAS f32x4*)(out + (size_t)m * D) + lane + 64 * j) = v[j]; }
            const float rs2 = 1.0f / sqrtf(wave_sum(s2) * (1.f / 1024.f) + EPS);
            GAS unsigned long long* o8 = (GAS unsigned long long*)(HN + (size_t)m * D) + lane;
#pragma unroll
            for (int j = 0; j < 4; ++j) { const f32x4 g = g2[64 * j];
                o8[64 * j] = (unsigned long long)pk2(v[j].x * rs2 * g.x, v[j].y * rs2 * g.y) | ((unsigned long long)pk2(v[j].z * rs2 * g.z, v[j].w * rs2 * g.w) << 32); }
        }
    }
    SEAM(7);

    if (IN(8)) for (int rep_ = 0; rep_ <= ((PROBE_REP_MASK >> 8) & 1); ++rep_) {
        pg8::Gemm g{HN, WT_ff1, D, D, D, 256}; pg8::StaticOrder S; S.init(M, FF, G, bx); pg8::EpiRelu2 E{F1, FF};
        pg8::gemm_phase<pg8::EpiRelu2, pg8::StaticOrder, true>(lds, g, S, E, wave);
    }
    SEAM(8);

    if (IN(9)) for (int rep_ = 0; rep_ <= ((PROBE_REP_MASK >> 9) & 1); ++rep_) {
        pg8::Gemm g{F1, WT_ff2, FF, FF, FF, 256}; pg8::StaticOrder S; S.init(M, D, G, bx); pg8::EpiF32 E{T2, D};
        pg8::gemm_phase<pg8::EpiF32, pg8::StaticOrder, true>(lds, g, S, E, wave);
    }
    SEAM(9);

    if (IN(10)) {
        PHASE_IDS();
        const float* gfpost_p = g_ffn_post;
        for (int m = gw; m < M; m += NGW) {
            const GAS f32x4* tr = (const GAS f32x4*)(T2 + (size_t)m * D) + lane; GAS f32x4* orow = (GAS f32x4*)(out + (size_t)m * D) + lane;
            const GAS f32x4* g1 = (const GAS f32x4*)gfpost_p + lane;
            f32x4 v[4]; float s = 0.f;
#pragma unroll
            for (int j = 0; j < 4; ++j) { v[j] = tr[64 * j]; s += (v[j].x * v[j].x + v[j].y * v[j].y) + (v[j].z * v[j].z + v[j].w * v[j].w); }
            const float rs = 1.0f / sqrtf(wave_sum(s) * (1.f / 1024.f) + EPS);
#pragma unroll
            for (int j = 0; j < 4; ++j) { const f32x4 g = g1[64 * j], hv = orow[64 * j];
                orow[64 * j] = (f32x4){hv.x + v[j].x * rs * g.x, hv.y + v[j].y * rs * g.y, hv.z + v[j].z * rs * g.z, hv.w + v[j].w * rs * g.w}; }
        }
    }
#undef IN
#undef SEAM
#undef x_in
#undef meta_tokens
#undef g_mix_pre
#undef w_in
#undef w_gate_up
#undef b_gate
#undef gla_norm_g
#undef w_o_gla
#undef a_re
#undef a_im
#undef log_step
#undef b_re
#undef b_im
#undef c_re
#undef c_im
#undef d_skip
#undef w_glu
#undef b_glu
#undef w_out
#undef g_mix_post
#undef g_ffn_pre
#undef w_ff1
#undef w_ff2
#undef g_ffn_post
}

extern "C" void kernel_launch(void* const* d_in, const int* in_sizes, int n_in, void* d_out, int out_size, void* d_ws, size_t ws_size, hipStream_t stream) {
    static int grid = 0;
    if (grid == 0) {
        if (n_in != 24 || in_sizes[0] != M * D || out_size != M * D || ws_size < WS_END) { fprintf(stderr, "kernel_launch: unexpected shapes (n_in %d, in0 %d, out %d, ws %zu)\n", n_in, n_in > 0 ? in_sizes[0] : -1, out_size, ws_size); grid = -1; return; }
        int dev = 0, cus = 0;
        if (hipGetDevice(&dev) != hipSuccess || hipDeviceGetAttribute(&cus, hipDeviceAttributeMultiprocessorCount, dev) != hipSuccess) { grid = -1; return; }
        if (hipFuncSetAttribute((const void*)fwd_kernel, hipFuncAttributeMaxDynamicSharedMemorySize, LDS_BYTES) != hipSuccess) { fprintf(stderr, "kernel_launch: hipFuncSetAttribute failed\n"); grid = -1; return; }
        int per_cu = 0;
        if (hipOccupancyMaxActiveBlocksPerMultiprocessor(&per_cu, (const void*)fwd_kernel, NWAVES * 64, LDS_BYTES) != hipSuccess || per_cu < 1) fprintf(stderr, "kernel_launch: occupancy query says %d\n", per_cu);
        (void)hipGetLastError();
        if (cus < 256) { fprintf(stderr, "kernel_launch: this kernel needs 256 CUs (one resident workgroup each), device has %d\n", cus); grid = -1; return; }
        grid = 256;
    }
    if (grid < 0) return;
    if (hipMemsetAsync((char*)d_ws + WS_CTL, 0, CTL_ZERO_BYTES, stream) != hipSuccess) return;
    Args a{};
    for (int i = 0; i < 24; ++i) a.in[i] = (const float*)d_in[i];
    a.out = (float*)d_out; a.ws = (unsigned char*)d_ws;
    if (N_LAUNCHES == 1) {
        a.ph_lo = 0; a.ph_hi = N_PHASES; a.li = 0;
        hipLaunchKernelGGL(fwd_kernel, dim3(grid), dim3(NWAVES * 64), LDS_BYTES, stream, a);
    } else {
        for (int li = 0; li < N_PHASES; ++li) { a.ph_lo = li; a.ph_hi = li + 1; a.li = li;
            hipLaunchKernelGGL(fwd_kernel, dim3(grid), dim3(NWAVES * 64), LDS_BYTES, stream, a); }
    }
}
```
